# Optimizing an MI355X kernel written in HIP

```python
import jax, jax.numpy as jnp
from jax import lax
import numpy as np

D_MODEL = 1024
BATCH = 16
SEQ = 2048
DEPTH = 1

ATTN_HEADS = 4
NOPE_DIM = 128
ROPE_DIM = 64
V_DIM = 128
QK_DIM = NOPE_DIM + ROPE_DIM
ATTN_WIDTH = ATTN_HEADS * V_DIM
Q_LORA = 384
KV_LORA = 256
POOL_GROUPS = 4
POOL_WINDOWS = (2, 4, 8, 16)
POOL_WIDTH = D_MODEL - ATTN_WIDTH
POOL_CH = POOL_WIDTH // POOL_GROUPS
MIX_WIDTH = ATTN_WIDTH + POOL_WIDTH
IN_WIDTH = Q_LORA + KV_LORA + ROPE_DIM + POOL_WIDTH
D_FF = 4 * D_MODEL
Q_BLOCK = 128
ROPE_THETA = 10000.0
EPS = 1e-6

kernel_name = "hymba_mla_multiscale_pool_block"


def rmsnorm(x, g):
    xf = x.astype(jnp.float32)
    y = xf * lax.rsqrt(jnp.mean(xf * xf, axis=-1, keepdims=True) + EPS)
    return (y * g.astype(jnp.float32)).astype(x.dtype)


def rope(x, cos, sin):
    half = x.shape[-1] // 2
    x1, x2 = x[..., :half], x[..., half:]
    xf1, xf2 = x1.astype(jnp.float32), x2.astype(jnp.float32)
    out = jnp.concatenate([xf1 * cos - xf2 * sin, xf2 * cos + xf1 * sin], axis=-1)
    return out.astype(x.dtype)


def mla(c_q, c_kv, k_r, q_norm_g, w_q_up, kv_norm_g, w_kv_up, positions):
    B, S, _ = c_q.shape
    q = (rmsnorm(c_q, q_norm_g) @ w_q_up).reshape(B, S, ATTN_HEADS, QK_DIM)
    kv = (rmsnorm(c_kv, kv_norm_g) @ w_kv_up).reshape(B, S, ATTN_HEADS, NOPE_DIM + V_DIM)
    q_nope, q_pe = q[..., :NOPE_DIM], q[..., NOPE_DIM:]
    k_nope, v = kv[..., :NOPE_DIM], kv[..., NOPE_DIM:]

    inv_freq = 1.0 / (ROPE_THETA ** (jnp.arange(0, ROPE_DIM, 2, dtype=jnp.float32) / ROPE_DIM))
    ang = positions.astype(jnp.float32)[..., None] * inv_freq
    cos, sin = jnp.cos(ang), jnp.sin(ang)
    q_pe = rope(q_pe, cos[:, :, None, :], sin[:, :, None, :])
    k_pe = rope(k_r, cos, sin)
    k_pe = jnp.broadcast_to(k_pe[:, :, None, :], (B, S, ATTN_HEADS, ROPE_DIM))

    q = jnp.concatenate([q_nope, q_pe], axis=-1).transpose(0, 2, 1, 3)
    k = jnp.concatenate([k_nope, k_pe], axis=-1).transpose(0, 2, 1, 3)
    v = v.transpose(0, 2, 1, 3)
    scale = QK_DIM ** -0.5
    nb = S // Q_BLOCK
    qb = q.reshape(B, ATTN_HEADS, nb, Q_BLOCK, QK_DIM).transpose(2, 0, 1, 3, 4)
    kpos = jnp.arange(S)

    def attend(args):
        qblk, i = args
        s = jnp.einsum('bhqd,bhkd->bhqk', qblk, k).astype(jnp.float32) * scale
        qpos = i * Q_BLOCK + jnp.arange(Q_BLOCK)
        mask = qpos[:, None] >= kpos[None, :]
        p = jax.nn.softmax(jnp.where(mask, s, -jnp.inf), axis=-1)
        return jnp.einsum('bhqk,bhkd->bhqd', p.astype(v.dtype), v)

    o = lax.map(attend, (qb, jnp.arange(nb)))
    return o.transpose(1, 0, 3, 2, 4).reshape(B, S, ATTN_WIDTH)


def multiscale_pool(u, pool_w, pool_scale):
    B, S, _ = u.shape
    ug = u.reshape(B, S, POOL_GROUPS, POOL_CH)
    t = jnp.arange(S)
    outs = []
    for g, w in enumerate(POOL_WINDOWS):
        xg = ug[:, :, g, :].astype(jnp.float32)
        cs = jnp.cumsum(xg, axis=1)
        lo = jnp.pad(cs, ((0, 0), (w, 0), (0, 0)))[:, :S]
        cnt = jnp.minimum(t + 1, w).astype(jnp.float32)[None, :, None]
        outs.append((cs - lo) / cnt - xg)
    pooled = jnp.stack(outs, axis=2).astype(u.dtype)
    y = jnp.einsum('bsgc,gcd->bsgd', pooled, pool_w).reshape(B, S, POOL_WIDTH)
    return y * pool_scale


def setup_inputs(seed: int = 0) -> dict:
    key = jax.random.key(seed)
    ks = jax.random.split(key, 20)
    f32 = jnp.float32

    def lin(k, shape, fan_in):
        return jax.random.normal(k, shape, f32) * fan_in ** -0.5

    def gain(k, shape):
        return 1.0 + 0.05 * jax.random.normal(k, shape, f32)

    x = jax.random.normal(ks[0], (BATCH, SEQ, D_MODEL), f32)
    offs = jax.random.randint(ks[1], (BATCH, 1), 0, 1024, dtype=jnp.int32)
    positions = offs + jnp.arange(SEQ, dtype=jnp.int32)[None, :]
    return {
        "x": x,
        "positions": positions,
        "norm_mix_g": gain(ks[2], (DEPTH, D_MODEL)),
        "w_in": lin(ks[3], (DEPTH, D_MODEL, IN_WIDTH), D_MODEL),
        "q_norm_g": gain(ks[4], (DEPTH, Q_LORA)),
        "w_q_up": lin(ks[5], (DEPTH, Q_LORA, ATTN_HEADS * QK_DIM), Q_LORA),
        "kv_norm_g": gain(ks[6], (DEPTH, KV_LORA)),
        "w_kv_up": lin(ks[7], (DEPTH, KV_LORA, ATTN_HEADS * (NOPE_DIM + V_DIM)), KV_LORA),
        "pool_w": lin(ks[8], (DEPTH, POOL_GROUPS, POOL_CH, POOL_CH), POOL_CH),
        "pool_scale": gain(ks[9], (DEPTH, POOL_WIDTH)),
        "w_out": lin(ks[10], (DEPTH, MIX_WIDTH, D_MODEL), MIX_WIDTH),
        "norm_mlp_g": gain(ks[11], (DEPTH, D_MODEL)),
        "w_mlp_up": lin(ks[12], (DEPTH, D_MODEL, D_FF), D_MODEL),
        "w_mlp_down": lin(ks[13], (DEPTH, D_FF, D_MODEL), D_FF),
        "norm_final_g": gain(ks[14], (D_MODEL,)),
    }


def reference(x, positions, norm_mix_g, w_in, q_norm_g, w_q_up, kv_norm_g, w_kv_up,
              pool_w, pool_scale, w_out, norm_mlp_g, w_mlp_up, w_mlp_down, norm_final_g):
    h = x
    for l in range(DEPTH):
        n = rmsnorm(h, norm_mix_g[l])
        proj = n @ w_in[l]
        c_q = proj[..., :Q_LORA]
        c_kv = proj[..., Q_LORA:Q_LORA + KV_LORA]
        k_r = proj[..., Q_LORA + KV_LORA:Q_LORA + KV_LORA + ROPE_DIM]
        u = proj[..., Q_LORA + KV_LORA + ROPE_DIM:]
        a = mla(c_q, c_kv, k_r, q_norm_g[l], w_q_up[l], kv_norm_g[l], w_kv_up[l], positions)
        p = multiscale_pool(u, pool_w[l], pool_scale[l])
        h = h + jnp.concatenate([a, p], axis=-1) @ w_out[l]
        m = rmsnorm(h, norm_mlp_g[l]) @ w_mlp_up[l]
        h = h + jnp.square(jax.nn.relu(m)) @ w_mlp_down[l]
    return rmsnorm(h, norm_final_g)
```

```cpp
#include <hip/hip_runtime.h>
#include <hip/hip_cooperative_groups.h>
#include <cstdio>
#include <cstdint>
namespace cg = cooperative_groups;
namespace pg8 {
#define PG8_LAS __attribute__((address_space(3)))
typedef unsigned short bf16_t;
typedef short bf16x8 __attribute__((ext_vector_type(8)));
typedef float f32x4 __attribute__((ext_vector_type(4)));
typedef unsigned u32x4 __attribute__((ext_vector_type(4)));
constexpr int BM = 256, BK = 64, HALF = 128, HTB = HALF * BK * 2  , STAGE_BYTES = 8 * HTB, NXCD = 8, WGM = 8;

__host__ __device__ __forceinline__ int lds_byte(int r, int c) { const int st = (r >> 4) * 2 + (c >> 5), rr = r & 15, cc = c & 31, ob = rr * 64 + cc * 2; return st * 1024 + (ob ^ (((ob >> 9) & 1) << 5)); }
__host__ __device__ __forceinline__ void stage_rc(int b, int& R, int& C) { const int st = b / 1024, sb = b % 1024, swz = sb ^ (((sb >> 9) & 1) << 5); R = (st >> 1) * 16 + swz / 64; C = (st & 1) * 32 + (swz % 64) / 2; }
__host__ __device__ __forceinline__ int perm32(int rho) { const int n = rho >> 4, i = rho & 15; return 8 * (i >> 2) + 4 * n + (i & 3); }

struct Unit { int pm, pn; };
struct Gemm { const bf16_t* A; const bf16_t* Bt; int M, N, K; };

struct StaticOrder {
    int nM, nN, nwg, G, c;
    __host__ __device__ void init(int M, int N, int G_, int c_) { nM = M / BM; nN = N / BM; nwg = nM * nN; G = G_; c = c_; }
    __host__ __device__ bool next(int i, Unit& u) const {
        const long L = (long)i * G + c; if (L >= nwg) return false;
        int wgid = (int)L; { const int q = nwg / NXCD, r = nwg % NXCD, xcd = wgid % NXCD, off = wgid / NXCD; wgid = (xcd < r ? xcd * (q + 1) : r * (q + 1) + (xcd - r) * q) + off; }
        const int nig = WGM * nN, gid = wgid / nig, fm = gid * WGM, gsz = (nM - fm) < WGM ? (nM - fm) : WGM;
        u.pm = fm + ((wgid % nig) % gsz); u.pn = (wgid % nig) / gsz; return true;
    }
    __device__ __forceinline__ void a_ready(const Unit&) const {}
    __device__ __forceinline__ void done(const Unit&) const {}
};

__device__ __forceinline__ unsigned cvt_pk_bf16(float lo, float hi) { unsigned r; asm volatile("v_cvt_pk_bf16_f32 %0, %1, %2" : "=v"(r) : "v"(lo), "v"(hi)); return r; }
typedef float f32x2 __attribute__((ext_vector_type(2)));
template <class Epi, class Sched, bool ALIGN_EPI = false, bool SP2 = false>
__device__ __forceinline__ void gemm_phase(PG8_LAS unsigned char* lds, const Gemm g, const Sched& S, const Epi& E) {
    int tid_l = threadIdx.x; asm volatile("" : "+v"(tid_l));
    const int tid = tid_l, wid = __builtin_amdgcn_readfirstlane(tid >> 6), lane = tid & 63, wr = wid >> 2, wc = wid & 3, fr = lane & 15, fq = lane >> 4;
    const int K = g.K, nt = K / BK;
    unsigned voffA[2], voffB[2];
#pragma unroll
    for (int i = 0; i < 2; ++i) { int R, C; stage_rc(tid * 16 + i * 8192, R, C); const int Rb = Epi::PERM ? ((R & ~31) + perm32(R & 31)) : R;
        voffA[i] = (unsigned)(R * K + C) * 2u; voffB[i] = (unsigned)(Rb * K + C) * 2u; }
    const size_t kstep = (size_t)(BK * 2);
    const size_t hstep = (size_t)HALF * K * 2;
    const size_t tstep = 2 * hstep;
    const unsigned ldsw = (unsigned)wid * 1024u;
    const int aoff = lds_byte(wr * 64 + fr, fq * 8), boff = lds_byte(wc * 32 + fr, fq * 8);
#define PG8_SA(b, h) (((b) * 2 + (h)) * HTB)
#define PG8_SB(b, h) ((4 + (b) * 2 + (h)) * HTB)
#define PG8_STAGE(bufoff, gbase, voff) do { _Pragma("unroll") for (int _i = 0; _i < 2; ++_i) \
        __builtin_amdgcn_global_load_lds((const unsigned*)((const char*)(gbase) + (voff)[_i]), (PG8_LAS unsigned*)(lds + (bufoff) + ldsw + _i * 8192), 16, 0, 0); } while (0)
#define PG8_LDA(dst, b, h) do { _Pragma("unroll") for (int m = 0; m < 4; ++m) _Pragma("unroll") for (int k = 0; k < 2; ++k) dst[m][k] = *(const PG8_LAS bf16x8*)(lds + PG8_SA(b, h) + aoff + m * 2048 + k * 1024); } while (0)
#define PG8_LDB(dst, b, h) do { _Pragma("unroll") for (int n = 0; n < 2; ++n) _Pragma("unroll") for (int k = 0; k < 2; ++k) dst[n][k] = *(const PG8_LAS bf16x8*)(lds + PG8_SB(b, h) + boff + n * 2048 + k * 1024); } while (0)
#define PG8_MMA(ai, bj, At, Bt) do { __builtin_amdgcn_s_setprio(1); _Pragma("unroll") for (int m = 0; m < 4; ++m) _Pragma("unroll") for (int n = 0; n < 2; ++n) _Pragma("unroll") for (int k = 0; k < 2; ++k) \
        acc[ai][bj][m][n] = __builtin_amdgcn_mfma_f32_16x16x32_bf16(Bt[n][k], At[m][k], acc[ai][bj][m][n], 0, 0, 0); __builtin_amdgcn_s_setprio(0); } while (0)
#define PG8_WAIT_V(n) asm volatile("s_waitcnt vmcnt(" #n ")" ::: "memory")
#define PG8_WAIT_L(n) asm volatile("s_waitcnt lgkmcnt(" #n ")" ::: "memory")
#define PG8_BAR __builtin_amdgcn_s_barrier()
#define PG8_SCHED __builtin_amdgcn_sched_barrier(0)
    Unit cur, nxt; int ui = 0;
    if (!S.next(0, cur)) return;
    f32x4 acc[2][2][4][2];
#pragma unroll
    for (int a = 0; a < 2; ++a)
#pragma unroll
        for (int b = 0; b < 2; ++b)
#pragma unroll
            for (int m = 0; m < 4; ++m)
#pragma unroll
                for (int n = 0; n < 2; ++n) acc[a][b][m][n] = (f32x4){0.f, 0.f, 0.f, 0.f};
    bf16x8 At[4][2], B0[2][2], B1[2][2];
    const char* cA = (const char*)g.A + (size_t)cur.pm * tstep; const char* cB = (const char*)g.Bt + (size_t)cur.pn * tstep;
    S.a_ready(cur);
    if constexpr (SP2) {
        PG8_STAGE(PG8_SB(0, 0), cB, voffB); PG8_STAGE(PG8_SB(0, 1), cB + hstep, voffB); PG8_STAGE(PG8_SA(0, 0), cA, voffA); PG8_STAGE(PG8_SA(0, 1), cA + hstep, voffA);
        if (wr == 1) PG8_BAR;
        PG8_WAIT_V(2); PG8_BAR;
        PG8_STAGE(PG8_SB(1, 0), cB + kstep, voffB); PG8_STAGE(PG8_SA(1, 0), cA + kstep, voffA); PG8_STAGE(PG8_SB(1, 1), cB + hstep + kstep, voffB);
        PG8_WAIT_V(6); PG8_BAR;
    } else {
        PG8_STAGE(PG8_SB(0, 0), cB, voffB); PG8_STAGE(PG8_SA(0, 0), cA, voffA); PG8_STAGE(PG8_SB(0, 1), cB + hstep, voffB); PG8_STAGE(PG8_SA(0, 1), cA + hstep, voffA);
        if (wr == 1) PG8_BAR;
        PG8_WAIT_V(4); PG8_BAR;
        PG8_STAGE(PG8_SB(1, 0), cB + kstep, voffB); PG8_STAGE(PG8_SA(1, 0), cA + kstep, voffA); PG8_STAGE(PG8_SB(1, 1), cB + hstep + kstep, voffB);
        PG8_WAIT_V(6); PG8_BAR;
    }
    for (;;) {
        const bool has_next = S.next(ui + 1, nxt);
        const char* nA = has_next ? (const char*)g.A + (size_t)nxt.pm * tstep : cA; const char* nB = has_next ? (const char*)g.Bt + (size_t)nxt.pn * tstep : cB;
#pragma unroll 1
        for (int t = 0; t < nt; t += 2) {
            const bool last = (t == nt - 2);
            const char* a1 = cA + (size_t)(t + 1) * kstep;
            const char* a2 = last ? nA : cA + (size_t)(t + 2) * kstep; const char* b2 = last ? nB : cB + (size_t)(t + 2) * kstep;
            const char* a3 = a2 + kstep; const char* b3 = b2 + kstep;
            if (last && has_next) S.a_ready(nxt);
            if constexpr (SP2) {
            PG8_LDB(B0, 0, 0); PG8_LDB(B1, 0, 1); PG8_SCHED; PG8_LDA(At, 0, 0); PG8_STAGE(PG8_SA(1, 1), a1 + hstep, voffA);
            PG8_WAIT_V(8); PG8_WAIT_L(0); PG8_BAR; PG8_MMA(0, 0, At, B0); PG8_MMA(0, 1, At, B1); PG8_BAR; PG8_SCHED;
            PG8_LDA(At, 0, 1); PG8_STAGE(PG8_SB(0, 0), b2, voffB); PG8_STAGE(PG8_SB(0, 1), b2 + hstep, voffB); PG8_STAGE(PG8_SA(0, 0), a2, voffA);
            PG8_WAIT_V(8); PG8_WAIT_L(0); PG8_BAR; PG8_MMA(1, 0, At, B0); PG8_MMA(1, 1, At, B1); PG8_BAR; PG8_SCHED;
            PG8_LDB(B0, 1, 0); PG8_LDB(B1, 1, 1); PG8_SCHED; PG8_LDA(At, 1, 0); PG8_STAGE(PG8_SA(0, 1), a2 + hstep, voffA);
            PG8_WAIT_V(8); PG8_WAIT_L(0); PG8_BAR; PG8_MMA(0, 0, At, B0); PG8_MMA(0, 1, At, B1); PG8_BAR; PG8_SCHED;
            PG8_LDA(At, 1, 1); PG8_STAGE(PG8_SB(1, 0), b3, voffB); PG8_STAGE(PG8_SB(1, 1), b3 + hstep, voffB); PG8_STAGE(PG8_SA(1, 0), a3, voffA);
            PG8_WAIT_V(8); PG8_WAIT_L(0); PG8_BAR; PG8_MMA(1, 0, At, B0); PG8_MMA(1, 1, At, B1); PG8_BAR; PG8_SCHED;
            } else {
            PG8_LDB(B0, 0, 0); PG8_SCHED; PG8_LDA(At, 0, 0); PG8_STAGE(PG8_SA(1, 1), a1 + hstep, voffA);
            PG8_WAIT_L(8); PG8_BAR; PG8_WAIT_L(0); PG8_MMA(0, 0, At, B0); PG8_BAR; PG8_SCHED;
            PG8_LDB(B1, 0, 1); PG8_STAGE(PG8_SB(0, 0), b2, voffB);
            PG8_BAR; PG8_WAIT_L(0); PG8_MMA(0, 1, At, B1); PG8_BAR;
            PG8_LDA(At, 0, 1); PG8_STAGE(PG8_SA(0, 0), a2, voffA);
            PG8_BAR; PG8_WAIT_L(0); PG8_MMA(1, 0, At, B0); PG8_BAR; PG8_SCHED;
            PG8_STAGE(PG8_SB(0, 1), b2 + hstep, voffB);
            PG8_WAIT_V(6); PG8_BAR; PG8_MMA(1, 1, At, B1); PG8_BAR;
            PG8_LDB(B0, 1, 0); PG8_SCHED; PG8_LDA(At, 1, 0); PG8_STAGE(PG8_SA(0, 1), a2 + hstep, voffA);
            PG8_WAIT_L(8); PG8_BAR; PG8_WAIT_L(0); PG8_MMA(0, 0, At, B0); PG8_BAR; PG8_SCHED;
            PG8_LDB(B1, 1, 1); PG8_STAGE(PG8_SB(1, 0), b3, voffB);
            PG8_BAR; PG8_WAIT_L(0); PG8_MMA(0, 1, At, B1); PG8_BAR;
            PG8_LDA(At, 1, 1); PG8_STAGE(PG8_SA(1, 0), a3, voffA);
            PG8_BAR; PG8_WAIT_L(0); PG8_MMA(1, 0, At, B0); PG8_BAR; PG8_SCHED;
            PG8_STAGE(PG8_SB(1, 1), b3 + hstep, voffB);
            PG8_WAIT_V(6); PG8_BAR; PG8_MMA(1, 1, At, B1); PG8_BAR;
            }
        }
        if constexpr (ALIGN_EPI) { if (wr == 0) PG8_BAR; }
        if constexpr (!Epi::AFTER_DRAIN) { E(acc, cur, wr, wc, fr, fq); S.done(cur); }
        if (!has_next) break;
#pragma unroll
        for (int a = 0; a < 2; ++a)
#pragma unroll
            for (int b = 0; b < 2; ++b)
#pragma unroll
                for (int m = 0; m < 4; ++m)
#pragma unroll
                    for (int n = 0; n < 2; ++n) acc[a][b][m][n] = (f32x4){0.f, 0.f, 0.f, 0.f};
        cur = nxt; cA = nA; cB = nB; ++ui;
        if constexpr (ALIGN_EPI) { if (wr == 1) PG8_BAR; }
    }
    PG8_WAIT_V(0);
    if constexpr (!ALIGN_EPI) { if (wr == 0) PG8_BAR; }
    PG8_BAR;
    if constexpr (Epi::AFTER_DRAIN) { E.fused(acc, cur, wr, wc, fr, fq, lds, wid, lane); S.done(cur); }
#undef PG8_SA
#undef PG8_SB
#undef PG8_STAGE
#undef PG8_LDA
#undef PG8_LDB
#undef PG8_MMA
#undef PG8_WAIT_V
#undef PG8_WAIT_L
#undef PG8_BAR
#undef PG8_SCHED
}
}

#define LAS __attribute__((address_space(3)))
using pg8::bf16_t; using pg8::bf16x8; using pg8::f32x4; using pg8::u32x4; using pg8::Unit; using pg8::cvt_pk_bf16;
typedef unsigned u32x2 __attribute__((ext_vector_type(2)));
typedef short s16x4 __attribute__((ext_vector_type(4)));
constexpr int T = 32768, SEQ = 2048, DM = 1024, NH = 4, QL = 384, KVL = 256, PW = 512, INW = 1216, FF = 4096;
constexpr int N1 = 1280;
constexpr float EPS = 1e-6f;
constexpr float QSCALE = 0.07216878364870322f * 1.4426950408889634f;
constexpr int NTHR = 512, NWAVES = 8;
constexpr int LDS_BYTES = 147456;

constexpr size_t MiB = 1u << 20;
constexpr size_t WS_WIN = 0, WS_WQ = 3 * MiB, WS_WK = 4 * MiB, WS_WV = 4 * MiB + 512 * 1024, WS_WO = 5 * MiB, WS_WUP = 7 * MiB, WS_WDN = 15 * MiB;
constexpr size_t WS_ROPE = 23 * MiB, WS_RSTDX = 31 * MiB, WS_SSQKV = 31 * MiB + 256 * 1024, WS_SSQQ = 32 * MiB, WS_SSQH = 33 * MiB, WS_SSQO = 35 * MiB;
constexpr size_t WS_HB = 40 * MiB, WS_XB = 104 * MiB, WS_CQ = 168 * MiB, WS_CKV = 192 * MiB, WS_KPE = 208 * MiB, WS_U = 212 * MiB, WS_Q = 244 * MiB, WS_KN = 292 * MiB,
                 WS_VT = 324 * MiB, WS_MIX = 356 * MiB, WS_ACT = 104 * MiB, WS_END = 420 * MiB;

__device__ __forceinline__ float bf2f(unsigned short h) { return __uint_as_float((unsigned)h << 16); }
__device__ __forceinline__ u32x4 pack8(const f32x4 a, const f32x4 b) { u32x4 w; w.x = cvt_pk_bf16(a[0], a[1]); w.y = cvt_pk_bf16(a[2], a[3]); w.z = cvt_pk_bf16(b[0], b[1]); w.w = cvt_pk_bf16(b[2], b[3]); return w; }
__device__ __forceinline__ u32x2 pack4(const f32x4 a) { u32x2 w; w.x = cvt_pk_bf16(a[0], a[1]); w.y = cvt_pk_bf16(a[2], a[3]); return w; }
__device__ __forceinline__ float wave_sum(float v) {
#pragma unroll
    for (int o = 1; o < 64; o <<= 1) v += __shfl_xor(v, o);
    return v;
}
__device__ __forceinline__ float quad_fq_sum(float s) { s += __shfl_xor(s, 16); s += __shfl_xor(s, 32); return s; }
__device__ __forceinline__ float dot4(const f32x4 a) { return (a[0] * a[0] + a[1] * a[1]) + (a[2] * a[2] + a[3] * a[3]); }

__device__ __forceinline__ int ropeperm(int y) { const int w = y >> 5, rem = y & 31, fq = rem >> 3, n = (rem >> 2) & 1, j = rem & 3; return 16 * w + 4 * fq + j + 32 * n; }
__device__ __forceinline__ int cm_win(int g) { if (g < 256) return 384 + g; if (g < 512) return g - 256; if (g < 640) return 256 + (g - 512); if (g < 704) return 640 + ropeperm(g - 640); if (g < 768) return -1; return 704 + (g - 768); }
__device__ __forceinline__ int cm_wq(int g) { if (g < 512) return (g >> 7) * 192 + (g & 127); const int x = g - 512; return (x >> 6) * 192 + 128 + ropeperm(x & 63); }
__device__ __forceinline__ int cm_wk(int g) { return (g >> 7) * 256 + (g & 127); }
__device__ __forceinline__ int cm_wv(int g) { return (g >> 7) * 256 + 128 + (g & 127); }

__device__ __forceinline__ void rope4(const f32x4 x1, const f32x4 x2, const float* cs, f32x4& lo, f32x4& hi) {
    const f32x4 t0 = *(const f32x4*)cs, t1 = *(const f32x4*)(cs + 4);
    const f32x4 c = {t0[0], t0[2], t1[0], t1[2]}, s = {t0[1], t0[3], t1[1], t1[3]};
    lo = x1 * c - x2 * s; hi = x2 * c + x1 * s;
}

struct Epi1 {
    static constexpr bool PERM = true, AFTER_DRAIN = false;
    const float* rstd_x; const float* rope; bf16_t* Ckv; bf16_t* Cq; bf16_t* Kpe; bf16_t* U; float* ssq_kv; float* ssq_q;
    __device__ __forceinline__ void operator()(const f32x4 (&acc)[2][2][4][2], const Unit& u, int wr, int wc, int fr, int fq) const {
        const int pn = u.pn, c8 = wc * 32 + 8 * fq;
#pragma unroll
        for (int ai = 0; ai < 2; ++ai)
#pragma unroll
            for (int m = 0; m < 4; ++m) {
                const int row = u.pm * 256 + ai * 128 + wr * 64 + m * 16 + fr;
                const float rs = rstd_x[row];
                f32x4 v[2][2];
#pragma unroll
                for (int bj = 0; bj < 2; ++bj)
#pragma unroll
                    for (int n = 0; n < 2; ++n) v[bj][n] = acc[ai][bj][m][n] * rs;
                if (pn == 0) {
                    *(u32x4*)(Ckv + (size_t)row * KVL + c8) = pack8(v[0][0], v[0][1]); *(u32x4*)(Ckv + (size_t)row * KVL + 128 + c8) = pack8(v[1][0], v[1][1]);
                    const float s = quad_fq_sum((dot4(v[0][0]) + dot4(v[0][1])) + (dot4(v[1][0]) + dot4(v[1][1])));
                    if (fq == 0) ssq_kv[row * 4 + wc] = s;
                } else if (pn == 1) {
                    *(u32x4*)(Cq + (size_t)row * QL + c8) = pack8(v[0][0], v[0][1]); *(u32x4*)(Cq + (size_t)row * QL + 128 + c8) = pack8(v[1][0], v[1][1]);
                    const float s = quad_fq_sum((dot4(v[0][0]) + dot4(v[0][1])) + (dot4(v[1][0]) + dot4(v[1][1])));
                    if (fq == 0) ssq_q[row * 8 + wc] = s;
                } else if (pn == 2) {
                    *(u32x4*)(Cq + (size_t)row * QL + 256 + c8) = pack8(v[0][0], v[0][1]);
                    const float s = quad_fq_sum(dot4(v[0][0]) + dot4(v[0][1]));
                    if (fq == 0) ssq_q[row * 8 + 4 + wc] = s;
                    if (wc < 2) { const int i0 = 16 * wc + 4 * fq; f32x4 lo, hi; rope4(v[1][0], v[1][1], rope + (size_t)row * 64 + 2 * i0, lo, hi);
                        *(u32x2*)(Kpe + (size_t)row * 64 + i0) = pack4(lo); *(u32x2*)(Kpe + (size_t)row * 64 + 32 + i0) = pack4(hi); }
                } else {
                    bf16_t* d = U + (size_t)row * PW + (pn - 3) * 256 + c8;
                    *(u32x4*)d = pack8(v[0][0], v[0][1]); *(u32x4*)(d + 128) = pack8(v[1][0], v[1][1]);
                }
                asm volatile("" ::: "memory");
            }
    }
};
struct Epi2 {
    static constexpr bool PERM = true, AFTER_DRAIN = false;
    const float* ssq_q; const float* rope; bf16_t* Q;
    __device__ __forceinline__ void operator()(const f32x4 (&acc)[2][2][4][2], const Unit& u, int wr, int wc, int fr, int fq) const {
        const int pn = u.pn, c8 = wc * 32 + 8 * fq;
#pragma unroll
        for (int ai = 0; ai < 2; ++ai)
#pragma unroll
            for (int m = 0; m < 4; ++m) {
                const int row = u.pm * 256 + ai * 128 + wr * 64 + m * 16 + fr;
                const f32x4 p0 = *(const f32x4*)(ssq_q + row * 8), p1 = *(const f32x4*)(ssq_q + row * 8 + 4);
                const float rs = rsqrtf(((p0[0] + p0[1]) + (p0[2] + p0[3]) + (p1[0] + p1[1]) + (p1[2] + p1[3])) * (1.0f / QL) + EPS) * QSCALE;
                bf16_t* qrow = Q + (size_t)row * 768;
#pragma unroll
                for (int bj = 0; bj < 2; ++bj) {
                    const f32x4 v0 = acc[ai][bj][m][0] * rs, v1 = acc[ai][bj][m][1] * rs;
                    if (pn < 2) { *(u32x4*)(qrow + (pn * 2 + bj) * 192 + c8) = pack8(v0, v1); }
                    else { const int head = 2 * bj + (wc >> 1), i0 = 16 * (wc & 1) + 4 * fq; f32x4 lo, hi; rope4(v0, v1, rope + (size_t)row * 64 + 2 * i0, lo, hi);
                        *(u32x2*)(qrow + head * 192 + 128 + i0) = pack4(lo); *(u32x2*)(qrow + head * 192 + 160 + i0) = pack4(hi); }
                }
                asm volatile("" ::: "memory");
            }
    }
};
struct Epi3a {
    static constexpr bool PERM = true, AFTER_DRAIN = false;
    const float* ssq_kv; bf16_t* Kn;
    __device__ __forceinline__ void operator()(const f32x4 (&acc)[2][2][4][2], const Unit& u, int wr, int wc, int fr, int fq) const {
        const int c8 = u.pn * 256 + wc * 32 + 8 * fq;
#pragma unroll
        for (int ai = 0; ai < 2; ++ai)
#pragma unroll
            for (int m = 0; m < 4; ++m) {
                const int row = u.pm * 256 + ai * 128 + wr * 64 + m * 16 + fr;
                const f32x4 p0 = *(const f32x4*)(ssq_kv + row * 4);
                const float rs = rsqrtf(((p0[0] + p0[1]) + (p0[2] + p0[3])) * (1.0f / KVL) + EPS);
#pragma unroll
                for (int bj = 0; bj < 2; ++bj) *(u32x4*)(Kn + (size_t)row * 512 + bj * 128 + c8) = pack8(acc[ai][bj][m][0] * rs, acc[ai][bj][m][1] * rs);
                asm volatile("" ::: "memory");
            }
    }
};
struct Epi3b {
    static constexpr bool PERM = true, AFTER_DRAIN = false;
    const float* ssq_kv; bf16_t* Vt;
    __device__ __forceinline__ void operator()(const f32x4 (&acc)[2][2][4][2], const Unit& u, int wr, int wc, int fr, int fq) const {
        const int t8 = u.pn * 256 + wc * 32 + 8 * fq;
#pragma unroll
        for (int bj = 0; bj < 2; ++bj) {
            f32x4 rs[2];
#pragma unroll
            for (int e = 0; e < 8; ++e) { const f32x4 p0 = *(const f32x4*)(ssq_kv + (size_t)(t8 + bj * 128 + e) * 4);
                rs[e >> 2][e & 3] = rsqrtf(((p0[0] + p0[1]) + (p0[2] + p0[3])) * (1.0f / KVL) + EPS); }
#pragma unroll
            for (int ai = 0; ai < 2; ++ai)
#pragma unroll
                for (int m = 0; m < 4; ++m) {
                    const int hv = u.pm * 256 + ai * 128 + wr * 64 + m * 16 + fr;
                    *(u32x4*)(Vt + (size_t)hv * T + bj * 128 + t8) = pack8(acc[ai][bj][m][0] * rs[0], acc[ai][bj][m][1] * rs[1]);
                }
            asm volatile("" ::: "memory");
        }
    }
};
struct Epi4 {
    static constexpr bool PERM = true, AFTER_DRAIN = false;
    const float* x; float* out; bf16_t* Hb; float* ssq_h;
    __device__ __forceinline__ void operator()(const f32x4 (&acc)[2][2][4][2], const Unit& u, int wr, int wc, int fr, int fq) const {
        const int c8 = u.pn * 256 + wc * 32 + 8 * fq;
#pragma unroll
        for (int ai = 0; ai < 2; ++ai)
#pragma unroll
            for (int m = 0; m < 4; ++m) {
                const int row = u.pm * 256 + ai * 128 + wr * 64 + m * 16 + fr;
                float s = 0.f;
#pragma unroll
                for (int bj = 0; bj < 2; ++bj) { const size_t off = (size_t)row * DM + bj * 128 + c8;
                    const f32x4 h0 = *(const f32x4*)(x + off) + acc[ai][bj][m][0], h1 = *(const f32x4*)(x + off + 4) + acc[ai][bj][m][1];
                    *(f32x4*)(out + off) = h0; *(f32x4*)(out + off + 4) = h1; *(u32x4*)(Hb + off) = pack8(h0, h1); s += dot4(h0) + dot4(h1); }
                s = quad_fq_sum(s);
                if (fq == 0) ssq_h[row * 16 + u.pn * 4 + wc] = s;
                asm volatile("" ::: "memory");
            }
    }
};
struct Epi5 {
    static constexpr bool PERM = true, AFTER_DRAIN = false;
    const float* ssq_h; bf16_t* Act;
    __device__ __forceinline__ void operator()(const f32x4 (&acc)[2][2][4][2], const Unit& u, int wr, int wc, int fr, int fq) const {
        const int c8 = u.pn * 256 + wc * 32 + 8 * fq;
#pragma unroll
        for (int ai = 0; ai < 2; ++ai)
#pragma unroll
            for (int m = 0; m < 4; ++m) {
                const int row = u.pm * 256 + ai * 128 + wr * 64 + m * 16 + fr;
                const f32x4 p0 = *(const f32x4*)(ssq_h + row * 16), p1 = *(const f32x4*)(ssq_h + row * 16 + 4), p2 = *(const f32x4*)(ssq_h + row * 16 + 8), p3 = *(const f32x4*)(ssq_h + row * 16 + 12);
                const f32x4 ps = (p0 + p1) + (p2 + p3);
                const float rs = rsqrtf(((ps[0] + ps[1]) + (ps[2] + ps[3])) * (1.0f / DM) + EPS);
#pragma unroll
                for (int bj = 0; bj < 2; ++bj) { f32x4 v0 = acc[ai][bj][m][0] * rs, v1 = acc[ai][bj][m][1] * rs;
#pragma unroll
                    for (int e = 0; e < 4; ++e) { const float a = fmaxf(v0[e], 0.f), b = fmaxf(v1[e], 0.f); v0[e] = a * a; v1[e] = b * b; }
                    *(u32x4*)(Act + (size_t)row * FF + bj * 128 + c8) = pack8(v0, v1); }
                asm volatile("" ::: "memory");
            }
    }
};
struct Epi6 {
    static constexpr bool PERM = true, AFTER_DRAIN = false;
    float* out; float* ssq_o;
    __device__ __forceinline__ void operator()(const f32x4 (&acc)[2][2][4][2], const Unit& u, int wr, int wc, int fr, int fq) const {
        const int c8 = u.pn * 256 + wc * 32 + 8 * fq;
#pragma unroll
        for (int ai = 0; ai < 2; ++ai)
#pragma unroll
            for (int m = 0; m < 4; ++m) {
                const int row = u.pm * 256 + ai * 128 + wr * 64 + m * 16 + fr;
                float s = 0.f;
#pragma unroll
                for (int bj = 0; bj < 2; ++bj) { const size_t off = (size_t)row * DM + bj * 128 + c8;
                    const f32x4 h0 = *(const f32x4*)(out + off) + acc[ai][bj][m][0], h1 = *(const f32x4*)(out + off + 4) + acc[ai][bj][m][1];
                    *(f32x4*)(out + off) = h0; *(f32x4*)(out + off + 4) = h1; s += dot4(h0) + dot4(h1); }
                s = quad_fq_sum(s);
                if (fq == 0) ssq_o[row * 16 + u.pn * 4 + wc] = s;
                asm volatile("" ::: "memory");
            }
    }
};

#define LDS_WAIT() asm volatile("s_waitcnt lgkmcnt(0)" ::: "memory")
template <int MAT>
__device__ __forceinline__ void tr_item(const float* __restrict__ W, int ldw, const float* __restrict__ gain, bf16_t* __restrict__ WT, int ldd, int nblk, LAS float* scr, int item, int lane) {
    const int kb = item / nblk, nb = item % nblk, k0 = 64 * kb, n0 = 32 * nb, gcol = n0 + (lane & 31);
    const int sc = MAT == 0 ? cm_win(gcol) : MAT == 1 ? cm_wq(gcol) : MAT == 2 ? cm_wk(gcol) : MAT == 3 ? cm_wv(gcol) : gcol;
#pragma unroll 8
    for (int i = 0; i < 32; ++i) { const int kk = 2 * i + (lane >> 5); float v = 0.f;
        if (sc >= 0) { v = W[(size_t)(k0 + kk) * ldw + sc]; if (gain) v *= gain[k0 + kk]; }
        scr[kk * 33 + (lane & 31)] = v; }
    LDS_WAIT(); asm volatile("" ::: "memory");
    const int c = lane & 7;
#pragma unroll
    for (int j = 0; j < 4; ++j) { const int n = (lane >> 3) + 8 * j; const LAS float* s = scr + (8 * c) * 33 + n;
        u32x4 o; o.x = cvt_pk_bf16(s[0 * 33], s[1 * 33]); o.y = cvt_pk_bf16(s[2 * 33], s[3 * 33]); o.z = cvt_pk_bf16(s[4 * 33], s[5 * 33]); o.w = cvt_pk_bf16(s[6 * 33], s[7 * 33]);
        *(u32x4*)(WT + (size_t)(n0 + n) * ldd + k0 + 8 * c) = o; }
    LDS_WAIT(); asm volatile("" ::: "memory");
}

constexpr int KN_B = 64 * 256, KR_B = 64 * 128, VT_B = 128 * 128, STG_B = KN_B + KR_B + VT_B;
static_assert(2 * STG_B <= 131072, "attention LDS");

__device__ __forceinline__ void attn_unit(LAS unsigned char* lds, const bf16_t* __restrict__ Q, const bf16_t* __restrict__ Kn, const bf16_t* __restrict__ Kpe,
                                          const bf16_t* __restrict__ Vt, bf16_t* __restrict__ Mix, int b, int h, int qb, int tid, int wid, int lane_in) {
    int lane = lane_in; asm volatile("" : "+v"(lane));
    const int fr = lane & 15, g = lane >> 4;
    const int q0 = qb * 256 + wid * 32;
    const size_t rb = (size_t)b * SEQ;
    bf16x8 qf[2][6];
#pragma unroll
    for (int q2 = 0; q2 < 2; ++q2)
#pragma unroll
        for (int ks = 0; ks < 6; ++ks) qf[q2][ks] = *(const bf16x8*)(Q + (rb + q0 + 16 * q2 + fr) * 768 + h * 192 + 32 * ks + 8 * g);
    f32x4 o[8][2];
#pragma unroll
    for (int vb = 0; vb < 8; ++vb) { o[vb][0] = (f32x4){0.f, 0.f, 0.f, 0.f}; o[vb][1] = (f32x4){0.f, 0.f, 0.f, 0.f}; }
    float mrun[2] = {-INFINITY, -INFINITY}, lrun[2] = {0.f, 0.f};
    const int nt = 4 * (qb + 1);
    unsigned oN[2], oV[2], oR;
#pragma unroll
    for (int r = 0; r < 2; ++r) { const int L = (r * 8 + wid) * 64 + lane;
        { const int key = L >> 4, pc = L & 15, cc = pc ^ (key & 15); oN[r] = (unsigned)(key * 1024 + cc * 16); }
        { const int vd = L >> 3, pc = L & 7, cc = pc ^ ((vd >> 1) & 7); oV[r] = (unsigned)(vd * (T * 2) + cc * 16); } }
    { const int L = wid * 64 + lane, key = L >> 3, pc = L & 7, cc = pc ^ ((key >> 1) & 7); oR = (unsigned)(key * 128 + cc * 16); }
    const char* bN = (const char*)(Kn + rb * 512 + h * 128); const char* bR = (const char*)(Kpe + rb * 64); const char* bV = (const char*)(Vt + (size_t)(h * 128) * T + rb);
#define ATT_DMA(kt, buf) do { LAS unsigned char* _d = lds + (buf) * STG_B; const char* _n = bN + (size_t)(kt) * (64 * 512 * 2); const char* _r = bR + (size_t)(kt) * (64 * 64 * 2); const char* _v = bV + (size_t)(kt) * 128; \
        __builtin_amdgcn_global_load_lds((const unsigned*)(_n + oN[0]), (LAS unsigned*)(_d + wid * 1024), 16, 0, 0); \
        __builtin_amdgcn_global_load_lds((const unsigned*)(_n + oN[1]), (LAS unsigned*)(_d + 8192 + wid * 1024), 16, 0, 0); \
        __builtin_amdgcn_global_load_lds((const unsigned*)(_r + oR), (LAS unsigned*)(_d + KN_B + wid * 1024), 16, 0, 0); \
        __builtin_amdgcn_global_load_lds((const unsigned*)(_v + oV[0]), (LAS unsigned*)(_d + KN_B + KR_B + wid * 1024), 16, 0, 0); \
        __builtin_amdgcn_global_load_lds((const unsigned*)(_v + oV[1]), (LAS unsigned*)(_d + KN_B + KR_B + 8192 + wid * 1024), 16, 0, 0); } while (0)
    const int swr = (fr >> 1) & 7;
    const int aN = fr * 256 + ((g ^ fr) << 4);
    const int aR = KN_B + fr * 128 + ((g ^ swr) << 4);
    const int aV = KN_B + KR_B + fr * 128 + (((g >> 1) ^ swr) << 4) + (g & 1) * 8;
    ATT_DMA(0, 0);
    asm volatile("s_waitcnt vmcnt(0)" ::: "memory");
    __syncthreads();
    for (int kt = 0; kt < nt; ++kt) {
        const int buf = kt & 1;
        if (kt + 1 < nt) ATT_DMA(kt + 1, buf ^ 1);
        if (kt * 64 <= q0 + 31) {
            LAS unsigned char* Sb = lds + buf * STG_B;
            f32x4 s[4][2];
#pragma unroll
            for (int kb = 0; kb < 4; ++kb) { s[kb][0] = (f32x4){0.f, 0.f, 0.f, 0.f}; s[kb][1] = (f32x4){0.f, 0.f, 0.f, 0.f}; }
#pragma unroll
            for (int ks = 0; ks < 6; ++ks) {
                bf16x8 kf[4];
#pragma unroll
                for (int kb = 0; kb < 4; ++kb) kf[kb] = (ks < 4) ? *(const LAS bf16x8*)(Sb + (aN ^ (ks * 64)) + kb * 4096) : *(const LAS bf16x8*)(Sb + (aR ^ ((ks - 4) * 64)) + kb * 2048);
#pragma unroll
                for (int kb = 0; kb < 4; ++kb) {
                    s[kb][0] = __builtin_amdgcn_mfma_f32_16x16x32_bf16(kf[kb], qf[0][ks], s[kb][0], 0, 0, 0);
                    s[kb][1] = __builtin_amdgcn_mfma_f32_16x16x32_bf16(kf[kb], qf[1][ks], s[kb][1], 0, 0, 0); }
            }
            if (kt * 64 + 63 > q0) {
#pragma unroll
                for (int q2 = 0; q2 < 2; ++q2) { const int qi = q0 + 16 * q2 + fr;
#pragma unroll
                    for (int kb = 0; kb < 4; ++kb)
#pragma unroll
                        for (int i = 0; i < 4; ++i) if (kt * 64 + 16 * kb + 4 * g + i > qi) s[kb][q2][i] = -INFINITY; }
            }
            bf16x8 pb[2][2];
#pragma unroll
            for (int q2 = 0; q2 < 2; ++q2) {
                float mx = fmaxf(fmaxf(s[0][q2][0], s[0][q2][1]), fmaxf(s[0][q2][2], s[0][q2][3]));
#pragma unroll
                for (int kb = 1; kb < 4; ++kb) mx = fmaxf(mx, fmaxf(fmaxf(s[kb][q2][0], s[kb][q2][1]), fmaxf(s[kb][q2][2], s[kb][q2][3])));
                mx = fmaxf(mx, __shfl_xor(mx, 16)); mx = fmaxf(mx, __shfl_xor(mx, 32));
                const float mnew = fmaxf(mrun[q2], mx), alpha = __builtin_amdgcn_exp2f(mrun[q2] - mnew);
                mrun[q2] = mnew;
                float rsum = 0.f;
#pragma unroll
                for (int kb = 0; kb < 4; ++kb)
#pragma unroll
                    for (int i = 0; i < 4; ++i) { const float p = __builtin_amdgcn_exp2f(s[kb][q2][i] - mnew); s[kb][q2][i] = p; rsum += p; }
                lrun[q2] = lrun[q2] * alpha + rsum;
#pragma unroll
                for (int vb = 0; vb < 8; ++vb) o[vb][q2] = o[vb][q2] * alpha;
#pragma unroll
                for (int k2 = 0; k2 < 2; ++k2) { const u32x4 w = pack8(s[2 * k2][q2], s[2 * k2 + 1][q2]); pb[q2][k2] = __builtin_bit_cast(bf16x8, w); }
            }
#pragma unroll
            for (int k2 = 0; k2 < 2; ++k2)
#pragma unroll
                for (int vq = 0; vq < 2; ++vq) {
                    bf16x8 vf[4];
#pragma unroll
                    for (int v4 = 0; v4 < 4; ++v4) { const LAS unsigned char* vp = Sb + (aV ^ (k2 * 64)) + (4 * vq + v4) * 2048; const LAS unsigned char* vph = Sb + (aV ^ (k2 * 64) ^ 32) + (4 * vq + v4) * 2048;
                        const s16x4 lo = *(const LAS s16x4*)vp, hi = *(const LAS s16x4*)vph;
                        vf[v4] = (bf16x8){lo[0], lo[1], lo[2], lo[3], hi[0], hi[1], hi[2], hi[3]}; }
#pragma unroll
                    for (int v4 = 0; v4 < 4; ++v4) {
                        o[4 * vq + v4][0] = __builtin_amdgcn_mfma_f32_16x16x32_bf16(vf[v4], pb[0][k2], o[4 * vq + v4][0], 0, 0, 0);
                        o[4 * vq + v4][1] = __builtin_amdgcn_mfma_f32_16x16x32_bf16(vf[v4], pb[1][k2], o[4 * vq + v4][1], 0, 0, 0); }
                }
        }
        asm volatile("s_waitcnt vmcnt(0)" ::: "memory");
        __syncthreads();
    }
#undef ATT_DMA
#pragma unroll
    for (int q2 = 0; q2 < 2; ++q2) {
        const float l = quad_fq_sum(lrun[q2]), inv = 1.0f / l;
        bf16_t* orow = Mix + (rb + q0 + 16 * q2 + fr) * DM + h * 128 + 4 * g;
#pragma unroll
        for (int vb = 0; vb < 8; ++vb) *(u32x2*)(orow + 16 * vb) = pack4(o[vb][q2] * inv);
    }
}

struct Args { const float* in[15]; float* out; unsigned char* ws; };
__global__ void __launch_bounds__(NTHR, 2) mk_fwd(Args a) {
    extern __shared__ __attribute__((aligned(16))) unsigned char lds_raw[];
    LAS unsigned char* lds = (LAS unsigned char*)lds_raw;
    cg::grid_group grid = cg::this_grid();
    const int tid = threadIdx.x, lane = tid & 63, wid = __builtin_amdgcn_readfirstlane(tid >> 6);
    const int G = gridDim.x, bx = blockIdx.x, vcu = (G % 8 == 0) ? (bx % 8) * (G / 8) + bx / 8 : bx;
    const int gw = vcu * NWAVES + wid, NGW = G * NWAVES, gtid = bx * NTHR + tid, NT = G * NTHR;
    unsigned char* ws = a.ws;
    const float* x = a.in[0]; const int* pos = (const int*)a.in[1]; const float* g_mix = a.in[2]; const float* w_in = a.in[3]; const float* g_q = a.in[4]; const float* w_q = a.in[5];
    const float* g_kv = a.in[6]; const float* w_kv = a.in[7]; const float* pool_w = a.in[8]; const float* pool_s = a.in[9]; const float* w_out = a.in[10]; const float* g_mlp = a.in[11];
    const float* w_up = a.in[12]; const float* w_dn = a.in[13]; const float* g_fin = a.in[14]; float* out = a.out;
    bf16_t* Win_t = (bf16_t*)(ws + WS_WIN); bf16_t* Wq_t = (bf16_t*)(ws + WS_WQ); bf16_t* Wk_t = (bf16_t*)(ws + WS_WK); bf16_t* Wv_t = (bf16_t*)(ws + WS_WV); bf16_t* Wo_t = (bf16_t*)(ws + WS_WO);
    bf16_t* Wup_t = (bf16_t*)(ws + WS_WUP); bf16_t* Wdn_t = (bf16_t*)(ws + WS_WDN);
    float* rope = (float*)(ws + WS_ROPE); float* rstd_x = (float*)(ws + WS_RSTDX); float* ssq_kv = (float*)(ws + WS_SSQKV); float* ssq_q = (float*)(ws + WS_SSQQ);
    float* ssq_h = (float*)(ws + WS_SSQH); float* ssq_o = (float*)(ws + WS_SSQO);
    bf16_t* Hb = (bf16_t*)(ws + WS_HB); bf16_t* Xb = (bf16_t*)(ws + WS_XB); bf16_t* Cq = (bf16_t*)(ws + WS_CQ); bf16_t* Ckv = (bf16_t*)(ws + WS_CKV); bf16_t* Kpe = (bf16_t*)(ws + WS_KPE);
    bf16_t* U = (bf16_t*)(ws + WS_U); bf16_t* Qb = (bf16_t*)(ws + WS_Q); bf16_t* Kn = (bf16_t*)(ws + WS_KN); bf16_t* Vt = (bf16_t*)(ws + WS_VT); bf16_t* Mix = (bf16_t*)(ws + WS_MIX);
    bf16_t* Act = (bf16_t*)(ws + WS_ACT);

    #if !defined(ONLY) || ONLY == 0
    {
        LAS float* scr = (LAS float*)(lds + wid * 16384);
        constexpr int I_IN = 16 * (N1 / 32), I_Q = 6 * 24, I_K = 4 * 16, I_V = 4 * 16, I_O = 8 * 32, I_UP = 16 * 128, I_DN = 64 * 32;
        constexpr int NITEMS = I_IN + I_Q + I_K + I_V + I_O + I_UP + I_DN;
        for (int it = gw; it < NITEMS; it += NGW) {
            int r = it;
            if (r < I_UP) { tr_item<4>(w_up, FF, g_mlp, Wup_t, DM, FF / 32, scr, r, lane); continue; } r -= I_UP;
            if (r < I_DN) { tr_item<4>(w_dn, DM, nullptr, Wdn_t, FF, DM / 32, scr, r, lane); continue; } r -= I_DN;
            if (r < I_IN) { tr_item<0>(w_in, INW, g_mix, Win_t, DM, N1 / 32, scr, r, lane); continue; } r -= I_IN;
            if (r < I_Q) { tr_item<1>(w_q, 768, g_q, Wq_t, QL, 24, scr, r, lane); continue; } r -= I_Q;
            if (r < I_K) { tr_item<2>(w_kv, 1024, g_kv, Wk_t, KVL, 16, scr, r, lane); continue; } r -= I_K;
            if (r < I_V) { tr_item<3>(w_kv, 1024, g_kv, Wv_t, KVL, 16, scr, r, lane); continue; } r -= I_V;
            tr_item<4>(w_out, DM, nullptr, Wo_t, DM, 32, scr, r, lane);
        }
        for (int it = gtid; it < 65536; it += NT) {
            const int n = it & 1023, c8 = (it >> 10) & 15, gg = it >> 14;
            float accv[8];
#pragma unroll
            for (int cc = 0; cc < 8; ++cc) accv[cc] = 0.f;
            const float* pw = pool_w + (size_t)(gg * 128 + c8 * 8) * 128;
            for (int d = 0; d < 128; ++d) { const float wv = w_out[(size_t)(512 + gg * 128 + d) * DM + n] * pool_s[gg * 128 + d];
#pragma unroll
                for (int cc = 0; cc < 8; ++cc) accv[cc] += pw[cc * 128 + d] * wv; }
            u32x4 o; o.x = cvt_pk_bf16(accv[0], accv[1]); o.y = cvt_pk_bf16(accv[2], accv[3]); o.z = cvt_pk_bf16(accv[4], accv[5]); o.w = cvt_pk_bf16(accv[6], accv[7]);
            *(u32x4*)(Wo_t + (size_t)n * DM + 512 + gg * 128 + c8 * 8) = o;
        }
        for (int it = gtid; it < T * 32; it += NT) {
            const int row = it >> 5, i = it & 31;
            const float inv = exp2f(-(float)i * (13.287712379549449f / 32.0f));
            const float ang = (float)pos[row] * inv;
            double rev = (double)ang * 0.15915494309189535; rev -= rint(rev);
            const float fr_ = (float)rev;
            rope[2 * it] = __builtin_amdgcn_cosf(fr_); rope[2 * it + 1] = __builtin_amdgcn_sinf(fr_);
        }
        for (int row = gw; row < T; row += NGW) {
            const f32x4* xr = (const f32x4*)(x + (size_t)row * DM) + lane;
            f32x4 v[4]; float s = 0.f;
#pragma unroll
            for (int j = 0; j < 4; ++j) { v[j] = xr[64 * j]; s += dot4(v[j]); }
            s = wave_sum(s);
            if (lane == 0) rstd_x[row] = rsqrtf(s * (1.0f / DM) + EPS);
            u32x2* o8 = (u32x2*)(Xb + (size_t)row * DM) + lane;
#pragma unroll
            for (int j = 0; j < 4; ++j) o8[64 * j] = pack4(v[j]);
        }
    }
#endif
    grid.sync();
    #if !defined(ONLY) || ONLY == 1
    {
        pg8::Gemm g{Xb, Win_t, T, N1, DM}; pg8::StaticOrder S; S.init(T, N1, G, bx);
        Epi1 E{rstd_x, rope, Ckv, Cq, Kpe, U, ssq_kv, ssq_q};
        pg8::gemm_phase<Epi1, pg8::StaticOrder, true, true>(lds, g, S, E);
    }
#endif
    grid.sync();
    #if !defined(ONLY) || ONLY == 2
    {
#if !defined(SUB) || SUB == 0
        for (int it = gtid; it < T * 64; it += NT) {
            const int row = it >> 6, c8 = it & 63, gg = c8 >> 4, w = 2 << gg, sidx = row & (SEQ - 1), cnt = (sidx + 1 < w) ? sidx + 1 : w;
            float sum[8], cur[8];
            { const u32x4 r0 = *(const u32x4*)(U + (size_t)row * PW + c8 * 8);
#pragma unroll
              for (int e = 0; e < 4; ++e) { cur[2 * e] = __uint_as_float(r0[e] << 16); cur[2 * e + 1] = __uint_as_float(r0[e] & 0xffff0000u); sum[2 * e] = cur[2 * e]; sum[2 * e + 1] = cur[2 * e + 1]; } }
            for (int j = 1; j < cnt; ++j) { const u32x4 r0 = *(const u32x4*)(U + (size_t)(row - j) * PW + c8 * 8);
#pragma unroll
                for (int e = 0; e < 4; ++e) { sum[2 * e] += __uint_as_float(r0[e] << 16); sum[2 * e + 1] += __uint_as_float(r0[e] & 0xffff0000u); } }
            const float ic = 1.0f / (float)cnt;
            u32x4 o;
#pragma unroll
            for (int e = 0; e < 4; ++e) o[e] = cvt_pk_bf16(sum[2 * e] * ic - cur[2 * e], sum[2 * e + 1] * ic - cur[2 * e + 1]);
            *(u32x4*)(Mix + (size_t)row * DM + 512 + c8 * 8) = o;
        }
#endif
#if !defined(SUB) || SUB == 1
        { pg8::Gemm g{Cq, Wq_t, T, 768, QL}; pg8::StaticOrder S; S.init(T, 768, G, bx); Epi2 E{ssq_q, rope, Qb};
          pg8::gemm_phase<Epi2, pg8::StaticOrder, true, true>(lds, g, S, E); }
#endif
#if !defined(SUB) || SUB == 2
        { pg8::Gemm g{Ckv, Wk_t, T, 512, KVL}; pg8::StaticOrder S; S.init(T, 512, G, bx); Epi3a E{ssq_kv, Kn};
          pg8::gemm_phase<Epi3a, pg8::StaticOrder, true, true>(lds, g, S, E); }
#endif
#if !defined(SUB) || SUB == 3
        { pg8::Gemm g{Wv_t, Ckv, 512, T, KVL}; pg8::StaticOrder S; S.init(512, T, G, bx); Epi3b E{ssq_kv, Vt};
          pg8::gemm_phase<Epi3b, pg8::StaticOrder, true, true>(lds, g, S, E); }
#endif
    }
#endif
    grid.sync();
    #if !defined(ONLY) || ONLY == 3
    for (int p = vcu; p < 256; p += G) {
        const int bh = p >> 2, pi = p & 3, b = bh >> 2, h = bh & 3;
        attn_unit(lds, Qb, Kn, Kpe, Vt, Mix, b, h, 7 - pi, tid, wid, lane);
        attn_unit(lds, Qb, Kn, Kpe, Vt, Mix, b, h, pi, tid, wid, lane);
    }
#endif
    grid.sync();
    #if !defined(ONLY) || ONLY == 4
    {
        pg8::Gemm g{Mix, Wo_t, T, DM, DM}; pg8::StaticOrder S; S.init(T, DM, G, bx); Epi4 E{x, out, Hb, ssq_h};
        pg8::gemm_phase<Epi4, pg8::StaticOrder, true, true>(lds, g, S, E);
    }
#endif
    grid.sync();
    #if !defined(ONLY) || ONLY == 5
    {
        pg8::Gemm g{Hb, Wup_t, T, FF, DM}; pg8::StaticOrder S; S.init(T, FF, G, bx); Epi5 E{ssq_h, Act};
        pg8::gemm_phase<Epi5, pg8::StaticOrder, true, true>(lds, g, S, E);
    }
#endif
    grid.sync();
    #if !defined(ONLY) || ONLY == 6
    {
        pg8::Gemm g{Act, Wdn_t, T, DM, FF}; pg8::StaticOrder S; S.init(T, DM, G, bx); Epi6 E{out, ssq_o};
        pg8::gemm_phase<Epi6, pg8::StaticOrder, true, true>(lds, g, S, E);
    }
#endif
    grid.sync();
    #if !defined(ONLY) || ONLY == 7
    for (int row = gw; row < T; row += NGW) {
        float s = ssq_o[row * 16 + (lane & 15)];
        s += __shfl_xor(s, 1); s += __shfl_xor(s, 2); s += __shfl_xor(s, 4); s += __shfl_xor(s, 8);
        const float rs = rsqrtf(s * (1.0f / DM) + EPS);
        f32x4* orow = (f32x4*)(out + (size_t)row * DM) + lane; const f32x4* gr = (const f32x4*)g_fin + lane;
#pragma unroll
        for (int j = 0; j < 4; ++j) orow[64 * j] = orow[64 * j] * rs * gr[64 * j];
    }
#endif
}

extern "C" void kernel_launch(void* const* d_in, const int* in_sizes, int n_in, void* d_out, int out_size, void* d_ws, size_t ws_size, hipStream_t stream) {
    static int grid = 0;
    if (grid == 0) {
        if (n_in != 15 || in_sizes[0] != T * DM || out_size != T * DM || ws_size < WS_END) { fprintf(stderr, "kernel_launch: unexpected shapes (n_in %d, in0 %d, out %d, ws %zu); nothing launched\n", n_in, n_in > 0 ? in_sizes[0] : -1, out_size, ws_size); grid = -1; return; }
        int dev = 0, cus = 0, per_cu = 0;
        if (hipGetDevice(&dev) != hipSuccess || hipDeviceGetAttribute(&cus, hipDeviceAttributeMultiprocessorCount, dev) != hipSuccess) { grid = -1; return; }
        if (hipFuncSetAttribute((const void*)mk_fwd, hipFuncAttributeMaxDynamicSharedMemorySize, LDS_BYTES) != hipSuccess) { fprintf(stderr, "kernel_launch: hipFuncSetAttribute failed\n"); grid = -1; return; }
        if (hipOccupancyMaxActiveBlocksPerMultiprocessor(&per_cu, (const void*)mk_fwd, NTHR, LDS_BYTES) != hipSuccess || per_cu < 1) per_cu = 1;
        (void)hipGetLastError();
        grid = cus * per_cu;
    }
    if (grid < 0) return;
    Args a{};
    for (int i = 0; i < 15; ++i) a.in[i] = (const float*)d_in[i];
    a.out = (float*)d_out; a.ws = (unsigned char*)d_ws;
    void* args[] = {&a};
    const hipError_t e = hipLaunchCooperativeKernel((const void*)mk_fwd, dim3(grid), dim3(NTHR), args, LDS_BYTES, stream);
    if (e != hipSuccess) fprintf(stderr, "kernel_launch: cooperative launch failed: %s (grid %d)\n", hipGetErrorString(e), grid);
}
```

```cpp
#include <hip/hip_runtime.h>
#include <hip/hip_cooperative_groups.h>
#include <cstdio>
#include <cstdint>
namespace cg = cooperative_groups;
namespace pg8 {
#define PG8_LAS __attribute__((address_space(3)))
typedef unsigned short bf16_t;
typedef short bf16x8 __attribute__((ext_vector_type(8)));
typedef float f32x4 __attribute__((ext_vector_type(4)));
typedef unsigned u32x4 __attribute__((ext_vector_type(4)));
constexpr int BM = 256, BK = 64, HALF = 128, HTB = HALF * BK * 2  , STAGE_BYTES = 8 * HTB, NXCD = 8, WGM = 8;

__host__ __device__ __forceinline__ int lds_byte(int r, int c) { const int st = (r >> 4) * 2 + (c >> 5), rr = r & 15, cc = c & 31, ob = rr * 64 + cc * 2; return st * 1024 + (ob ^ (((ob >> 9) & 1) << 5)); }
__host__ __device__ __forceinline__ void stage_rc(int b, int& R, int& C) { const int st = b / 1024, sb = b % 1024, swz = sb ^ (((sb >> 9) & 1) << 5); R = (st >> 1) * 16 + swz / 64; C = (st & 1) * 32 + (swz % 64) / 2; }
__host__ __device__ __forceinline__ int perm32(int rho) { const int n = rho >> 4, i = rho & 15; return 8 * (i >> 2) + 4 * n + (i & 3); }

struct Unit { int pm, pn; };
struct Gemm { const bf16_t* A; const bf16_t* Bt; int M, N, K; };

struct StaticOrder {
    int nM, nN, nwg, G, c;
    __host__ __device__ void init(int M, int N, int G_, int c_) { nM = M / BM; nN = N / BM; nwg = nM * nN; G = G_; c = c_; }
    __host__ __device__ bool next(int i, Unit& u) const {
        const long L = (long)i * G + c; if (L >= nwg) return false;
        int wgid = (int)L; { const int q = nwg / NXCD, r = nwg % NXCD, xcd = wgid % NXCD, off = wgid / NXCD; wgid = (xcd < r ? xcd * (q + 1) : r * (q + 1) + (xcd - r) * q) + off; }
        const int nig = WGM * nN, gid = wgid / nig, fm = gid * WGM, gsz = (nM - fm) < WGM ? (nM - fm) : WGM;
        u.pm = fm + ((wgid % nig) % gsz); u.pn = (wgid % nig) / gsz; return true;
    }
    __device__ __forceinline__ void a_ready(const Unit&) const {}
    __device__ __forceinline__ void done(const Unit&) const {}
};

__device__ __forceinline__ unsigned cvt_pk_bf16(float lo, float hi) { unsigned r; asm volatile("v_cvt_pk_bf16_f32 %0, %1, %2" : "=v"(r) : "v"(lo), "v"(hi)); return r; }
typedef float f32x2 __attribute__((ext_vector_type(2)));
template <class Epi, class Sched, bool ALIGN_EPI = false, bool SP2 = false>
__device__ __forceinline__ void gemm_phase(PG8_LAS unsigned char* lds, const Gemm g, const Sched& S, const Epi& E) {
    int tid_l = threadIdx.x; asm volatile("" : "+v"(tid_l));
    const int tid = tid_l, wid = __builtin_amdgcn_readfirstlane(tid >> 6), lane = tid & 63, wr = wid >> 2, wc = wid & 3, fr = lane & 15, fq = lane >> 4;
    const int K = g.K, nt = K / BK;
    unsigned voffA[2], voffB[2];
#pragma unroll
    for (int i = 0; i < 2; ++i) { int R, C; stage_rc(tid * 16 + i * 8192, R, C); const int Rb = Epi::PERM ? ((R & ~31) + perm32(R & 31)) : R;
        voffA[i] = (unsigned)(R * K + C) * 2u; voffB[i] = (unsigned)(Rb * K + C) * 2u; }
    const size_t kstep = (size_t)(BK * 2);
    const size_t hstep = (size_t)HALF * K * 2;
    const size_t tstep = 2 * hstep;
    const unsigned ldsw = (unsigned)wid * 1024u;
    const int aoff = lds_byte(wr * 64 + fr, fq * 8), boff = lds_byte(wc * 32 + fr, fq * 8);
#define PG8_SA(b, h) (((b) * 2 + (h)) * HTB)
#define PG8_SB(b, h) ((4 + (b) * 2 + (h)) * HTB)
#define PG8_STAGE(bufoff, gbase, voff) do { _Pragma("unroll") for (int _i = 0; _i < 2; ++_i) \
        __builtin_amdgcn_global_load_lds((const unsigned*)((const char*)(gbase) + (voff)[_i]), (PG8_LAS unsigned*)(lds + (bufoff) + ldsw + _i * 8192), 16, 0, 0); } while (0)
#define PG8_LDA(dst, b, h) do { _Pragma("unroll") for (int m = 0; m < 4; ++m) _Pragma("unroll") for (int k = 0; k < 2; ++k) dst[m][k] = *(const PG8_LAS bf16x8*)(lds + PG8_SA(b, h) + aoff + m * 2048 + k * 1024); } while (0)
#define PG8_LDB(dst, b, h) do { _Pragma("unroll") for (int n = 0; n < 2; ++n) _Pragma("unroll") for (int k = 0; k < 2; ++k) dst[n][k] = *(const PG8_LAS bf16x8*)(lds + PG8_SB(b, h) + boff + n * 2048 + k * 1024); } while (0)
#define PG8_MMA(ai, bj, At, Bt) do { __builtin_amdgcn_s_setprio(1); _Pragma("unroll") for (int m = 0; m < 4; ++m) _Pragma("unroll") for (int n = 0; n < 2; ++n) _Pragma("unroll") for (int k = 0; k < 2; ++k) \
        acc[ai][bj][m][n] = __builtin_amdgcn_mfma_f32_16x16x32_bf16(Bt[n][k], At[m][k], acc[ai][bj][m][n], 0, 0, 0); __builtin_amdgcn_s_setprio(0); } while (0)
#define PG8_WAIT_V(n) asm volatile("s_waitcnt vmcnt(" #n ")" ::: "memory")
#define PG8_WAIT_L(n) asm volatile("s_waitcnt lgkmcnt(" #n ")" ::: "memory")
#define PG8_BAR __builtin_amdgcn_s_barrier()
#define PG8_SCHED __builtin_amdgcn_sched_barrier(0)
    Unit cur, nxt; int ui = 0;
    if (!S.next(0, cur)) return;
    f32x4 acc[2][2][4][2];
#pragma unroll
    for (int a = 0; a < 2; ++a)
#pragma unroll
        for (int b = 0; b < 2; ++b)
#pragma unroll
            for (int m = 0; m < 4; ++m)
#pragma unroll
                for (int n = 0; n < 2; ++n) acc[a][b][m][n] = (f32x4){0.f, 0.f, 0.f, 0.f};
    bf16x8 At[4][2], B0[2][2], B1[2][2];
    const char* cA = (const char*)g.A + (size_t)cur.pm * tstep; const char* cB = (const char*)g.Bt + (size_t)cur.pn * tstep;
    S.a_ready(cur);
    if constexpr (SP2) {
        PG8_STAGE(PG8_SB(0, 0), cB, voffB); PG8_STAGE(PG8_SB(0, 1), cB + hstep, voffB); PG8_STAGE(PG8_SA(0, 0), cA, voffA); PG8_STAGE(PG8_SA(0, 1), cA + hstep, voffA);
        if (wr == 1) PG8_BAR;
        PG8_WAIT_V(2); PG8_BAR;
        PG8_STAGE(PG8_SB(1, 0), cB + kstep, voffB); PG8_STAGE(PG8_SA(1, 0), cA + kstep, voffA); PG8_STAGE(PG8_SB(1, 1), cB + hstep + kstep, voffB);
        PG8_WAIT_V(6); PG8_BAR;
    } else {
        PG8_STAGE(PG8_SB(0, 0), cB, voffB); PG8_STAGE(PG8_SA(0, 0), cA, voffA); PG8_STAGE(PG8_SB(0, 1), cB + hstep, voffB); PG8_STAGE(PG8_SA(0, 1), cA + hstep, voffA);
        if (wr == 1) PG8_BAR;
        PG8_WAIT_V(4); PG8_BAR;
        PG8_STAGE(PG8_SB(1, 0), cB + kstep, voffB); PG8_STAGE(PG8_SA(1, 0), cA + kstep, voffA); PG8_STAGE(PG8_SB(1, 1), cB + hstep + kstep, voffB);
        PG8_WAIT_V(6); PG8_BAR;
    }
    for (;;) {
        const bool has_next = S.next(ui + 1, nxt);
        const char* nA = has_next ? (const char*)g.A + (size_t)nxt.pm * tstep : cA; const char* nB = has_next ? (const char*)g.Bt + (size_t)nxt.pn * tstep : cB;
#pragma unroll 1
        for (int t = 0; t < nt; t += 2) {
            const bool last = (t == nt - 2);
            const char* a1 = cA + (size_t)(t + 1) * kstep;
            const char* a2 = last ? nA : cA + (size_t)(t + 2) * kstep; const char* b2 = last ? nB : cB + (size_t)(t + 2) * kstep;
            const char* a3 = a2 + kstep; const char* b3 = b2 + kstep;
            if (last && has_next) S.a_ready(nxt);
            if constexpr (SP2) {
            PG8_LDB(B0, 0, 0); PG8_LDB(B1, 0, 1); PG8_SCHED; PG8_LDA(At, 0, 0); PG8_STAGE(PG8_SA(1, 1), a1 + hstep, voffA);
            PG8_WAIT_V(8); PG8_WAIT_L(0); PG8_BAR; PG8_MMA(0, 0, At, B0); PG8_MMA(0, 1, At, B1); PG8_BAR; PG8_SCHED;
            PG8_LDA(At, 0, 1); PG8_STAGE(PG8_SB(0, 0), b2, voffB); PG8_STAGE(PG8_SB(0, 1), b2 + hstep, voffB); PG8_STAGE(PG8_SA(0, 0), a2, voffA);
            PG8_WAIT_V(8); PG8_WAIT_L(0); PG8_BAR; PG8_MMA(1, 0, At, B0); PG8_MMA(1, 1, At, B1); PG8_BAR; PG8_SCHED;
            PG8_LDB(B0, 1, 0); PG8_LDB(B1, 1, 1); PG8_SCHED; PG8_LDA(At, 1, 0); PG8_STAGE(PG8_SA(0, 1), a2 + hstep, voffA);
            PG8_WAIT_V(8); PG8_WAIT_L(0); PG8_BAR; PG8_MMA(0, 0, At, B0); PG8_MMA(0, 1, At, B1); PG8_BAR; PG8_SCHED;
            PG8_LDA(At, 1, 1); PG8_STAGE(PG8_SB(1, 0), b3, voffB); PG8_STAGE(PG8_SB(1, 1), b3 + hstep, voffB); PG8_STAGE(PG8_SA(1, 0), a3, voffA);
            PG8_WAIT_V(8); PG8_WAIT_L(0); PG8_BAR; PG8_MMA(1, 0, At, B0); PG8_MMA(1, 1, At, B1); PG8_BAR; PG8_SCHED;
            } else {
            PG8_LDB(B0, 0, 0); PG8_SCHED; PG8_LDA(At, 0, 0); PG8_STAGE(PG8_SA(1, 1), a1 + hstep, voffA);
            PG8_WAIT_L(8); PG8_BAR; PG8_WAIT_L(0); PG8_MMA(0, 0, At, B0); PG8_BAR; PG8_SCHED;
            PG8_LDB(B1, 0, 1); PG8_STAGE(PG8_SB(0, 0), b2, voffB);
            PG8_BAR; PG8_WAIT_L(0); PG8_MMA(0, 1, At, B1); PG8_BAR;
            PG8_LDA(At, 0, 1); PG8_STAGE(PG8_SA(0, 0), a2, voffA);
            PG8_BAR; PG8_WAIT_L(0); PG8_MMA(1, 0, At, B0); PG8_BAR; PG8_SCHED;
            PG8_STAGE(PG8_SB(0, 1), b2 + hstep, voffB);
            PG8_WAIT_V(6); PG8_BAR; PG8_MMA(1, 1, At, B1); PG8_BAR;
            PG8_LDB(B0, 1, 0); PG8_SCHED; PG8_LDA(At, 1, 0); PG8_STAGE(PG8_SA(0, 1), a2 + hstep, voffA);
            PG8_WAIT_L(8); PG8_BAR; PG8_WAIT_L(0); PG8_MMA(0, 0, At, B0); PG8_BAR; PG8_SCHED;
            PG8_LDB(B1, 1, 1); PG8_STAGE(PG8_SB(1, 0), b3, voffB);
            PG8_BAR; PG8_WAIT_L(0); PG8_MMA(0, 1, At, B1); PG8_BAR;
            PG8_LDA(At, 1, 1); PG8_STAGE(PG8_SA(1, 0), a3, voffA);
            PG8_BAR; PG8_WAIT_L(0); PG8_MMA(1, 0, At, B0); PG8_BAR; PG8_SCHED;
            PG8_STAGE(PG8_SB(1, 1), b3 + hstep, voffB);
            PG8_WAIT_V(6); PG8_BAR; PG8_MMA(1, 1, At, B1); PG8_BAR;
            }
        }
        if constexpr (ALIGN_EPI) { if (wr == 0) PG8_BAR; }
        if constexpr (!Epi::AFTER_DRAIN) { E(acc, cur, wr, wc, fr, fq); S.done(cur); }
        if (!has_next) break;
#pragma unroll
        for (int a = 0; a < 2; ++a)
#pragma unroll
            for (int b = 0; b < 2; ++b)
#pragma unroll
                for (int m = 0; m < 4; ++m)
#pragma unroll
                    for (int n = 0; n < 2; ++n) acc[a][b][m][n] = (f32x4){0.f, 0.f, 0.f, 0.f};
        cur = nxt; cA = nA; cB = nB; ++ui;
        if constexpr (ALIGN_EPI) { if (wr == 1) PG8_BAR; }
    }
    PG8_WAIT_V(0);
    if constexpr (!ALIGN_EPI) { if (wr == 0) PG8_BAR; }
    PG8_BAR;
    if constexpr (Epi::AFTER_DRAIN) { E.fused(acc, cur, wr, wc, fr, fq, lds, wid, lane); S.done(cur); }
#undef PG8_SA
#undef PG8_SB
#undef PG8_STAGE
#undef PG8_LDA
#undef PG8_LDB
#undef PG8_MMA
#undef PG8_WAIT_V
#undef PG8_WAIT_L
#undef PG8_BAR
#undef PG8_SCHED
}
}

#define LAS __attribute__((address_space(3)))
using pg8::bf16_t; using pg8::bf16x8; using pg8::f32x4; using pg8::u32x4; using pg8::Unit; using pg8::cvt_pk_bf16;
typedef unsigned u32x2 __attribute__((ext_vector_type(2)));
typedef short s16x4 __attribute__((ext_vector_type(4)));
constexpr int T = 32768, SEQ = 2048, DM = 1024, NH = 4, QL = 384, KVL = 256, PW = 512, INW = 1216, FF = 4096;
constexpr int N1 = 1280;
constexpr float EPS = 1e-6f;
constexpr float QSCALE = 0.07216878364870322f * 1.4426950408889634f;
constexpr int NTHR = 512, NWAVES = 8;
constexpr int LDS_BYTES = 147456;

constexpr size_t MiB = 1u << 20;
constexpr size_t WS_WIN = 0, WS_WQ = 3 * MiB, WS_WK = 4 * MiB, WS_WV = 4 * MiB + 512 * 1024, WS_WO = 5 * MiB, WS_WUP = 7 * MiB, WS_WDN = 15 * MiB;
constexpr size_t WS_ROPE = 23 * MiB, WS_RSTDX = 31 * MiB, WS_SSQKV = 31 * MiB + 256 * 1024, WS_SSQQ = 32 * MiB, WS_SSQH = 33 * MiB, WS_SSQO = 35 * MiB;
constexpr size_t WS_HB = 40 * MiB, WS_XB = 104 * MiB, WS_CQ = 168 * MiB, WS_CKV = 192 * MiB, WS_KPE = 208 * MiB, WS_U = 212 * MiB, WS_Q = 244 * MiB, WS_KN = 292 * MiB,
                 WS_VT = 324 * MiB, WS_MIX = 356 * MiB, WS_ACT = 104 * MiB, WS_H2 = 360 * MiB, WS_END = 488 * MiB;
constexpr size_t WS_CTL = 38 * MiB, CTL_BYTES = 16384;

__device__ __forceinline__ float bf2f(unsigned short h) { return __uint_as_float((unsigned)h << 16); }
__device__ __forceinline__ u32x4 pack8(const f32x4 a, const f32x4 b) { u32x4 w; w.x = cvt_pk_bf16(a[0], a[1]); w.y = cvt_pk_bf16(a[2], a[3]); w.z = cvt_pk_bf16(b[0], b[1]); w.w = cvt_pk_bf16(b[2], b[3]); return w; }
__device__ __forceinline__ u32x2 pack4(const f32x4 a) { u32x2 w; w.x = cvt_pk_bf16(a[0], a[1]); w.y = cvt_pk_bf16(a[2], a[3]); return w; }
__device__ __forceinline__ float wave_sum(float v) {
#pragma unroll
    for (int o = 1; o < 64; o <<= 1) v += __shfl_xor(v, o);
    return v;
}
__device__ __forceinline__ float quad_fq_sum(float s) { s += __shfl_xor(s, 16); s += __shfl_xor(s, 32); return s; }
__device__ __forceinline__ float dot4(const f32x4 a) { return (a[0] * a[0] + a[1] * a[1]) + (a[2] * a[2] + a[3] * a[3]); }

__device__ __forceinline__ int ropeperm(int y) { const int w = y >> 5, rem = y & 31, fq = rem >> 3, n = (rem >> 2) & 1, j = rem & 3; return 16 * w + 4 * fq + j + 32 * n; }
__device__ __forceinline__ int cm_win(int g) { if (g < 256) return 384 + g; if (g < 512) return g - 256; if (g < 640) return 256 + (g - 512); if (g < 704) return 640 + ropeperm(g - 640); if (g < 768) return -1; return 704 + (g - 768); }
__device__ __forceinline__ int cm_wq(int g) { if (g < 512) return (g >> 7) * 192 + (g & 127); const int x = g - 512; return (x >> 6) * 192 + 128 + ropeperm(x & 63); }
__device__ __forceinline__ int cm_wk(int g) { return (g >> 7) * 256 + (g & 127); }
__device__ __forceinline__ int cm_wv(int g) { return (g >> 7) * 256 + 128 + (g & 127); }

__device__ __forceinline__ void rope4(const f32x4 x1, const f32x4 x2, const float* cs, f32x4& lo, f32x4& hi) {
    const f32x4 t0 = *(const f32x4*)cs, t1 = *(const f32x4*)(cs + 4);
    const f32x4 c = {t0[0], t0[2], t1[0], t1[2]}, s = {t0[1], t0[3], t1[1], t1[3]};
    lo = x1 * c - x2 * s; hi = x2 * c + x1 * s;
}

struct Epi1 {
    static constexpr bool PERM = true, AFTER_DRAIN = false;
    const float* rstd_x; const float* rope; bf16_t* Ckv; bf16_t* Cq; bf16_t* Kpe; bf16_t* U; float* ssq_kv; float* ssq_q;
    __device__ __forceinline__ void operator()(const f32x4 (&acc)[2][2][4][2], const Unit& u, int wr, int wc, int fr, int fq) const {
        const int pn = u.pn, c8 = wc * 32 + 8 * fq;
#pragma unroll
        for (int ai = 0; ai < 2; ++ai)
#pragma unroll
            for (int m = 0; m < 4; ++m) {
                const int row = u.pm * 256 + ai * 128 + wr * 64 + m * 16 + fr;
                const float rs = rstd_x[row];
                f32x4 v[2][2];
#pragma unroll
                for (int bj = 0; bj < 2; ++bj)
#pragma unroll
                    for (int n = 0; n < 2; ++n) v[bj][n] = acc[ai][bj][m][n] * rs;
                if (pn == 0) {
                    *(u32x4*)(Ckv + (size_t)row * KVL + c8) = pack8(v[0][0], v[0][1]); *(u32x4*)(Ckv + (size_t)row * KVL + 128 + c8) = pack8(v[1][0], v[1][1]);
                    const float s = quad_fq_sum((dot4(v[0][0]) + dot4(v[0][1])) + (dot4(v[1][0]) + dot4(v[1][1])));
                    if (fq == 0) ssq_kv[row * 4 + wc] = s;
                } else if (pn == 1) {
                    *(u32x4*)(Cq + (size_t)row * QL + c8) = pack8(v[0][0], v[0][1]); *(u32x4*)(Cq + (size_t)row * QL + 128 + c8) = pack8(v[1][0], v[1][1]);
                    const float s = quad_fq_sum((dot4(v[0][0]) + dot4(v[0][1])) + (dot4(v[1][0]) + dot4(v[1][1])));
                    if (fq == 0) ssq_q[row * 8 + wc] = s;
                } else if (pn == 2) {
                    *(u32x4*)(Cq + (size_t)row * QL + 256 + c8) = pack8(v[0][0], v[0][1]);
                    const float s = quad_fq_sum(dot4(v[0][0]) + dot4(v[0][1]));
                    if (fq == 0) ssq_q[row * 8 + 4 + wc] = s;
                    if (wc < 2) { const int i0 = 16 * wc + 4 * fq; f32x4 lo, hi; rope4(v[1][0], v[1][1], rope + (size_t)row * 64 + 2 * i0, lo, hi);
                        *(u32x2*)(Kpe + (size_t)row * 64 + i0) = pack4(lo); *(u32x2*)(Kpe + (size_t)row * 64 + 32 + i0) = pack4(hi); }
                } else {
                    bf16_t* d = U + (size_t)row * PW + (pn - 3) * 256 + c8;
                    *(u32x4*)d = pack8(v[0][0], v[0][1]); *(u32x4*)(d + 128) = pack8(v[1][0], v[1][1]);
                }
                asm volatile("" ::: "memory");
            }
    }
};
struct Epi2 {
    static constexpr bool PERM = true, AFTER_DRAIN = false;
    const float* ssq_q; const float* rope; bf16_t* Q;
    __device__ __forceinline__ void operator()(const f32x4 (&acc)[2][2][4][2], const Unit& u, int wr, int wc, int fr, int fq) const {
        const int pn = u.pn, c8 = wc * 32 + 8 * fq;
#pragma unroll
        for (int ai = 0; ai < 2; ++ai)
#pragma unroll
            for (int m = 0; m < 4; ++m) {
                const int row = u.pm * 256 + ai * 128 + wr * 64 + m * 16 + fr;
                const f32x4 p0 = *(const f32x4*)(ssq_q + row * 8), p1 = *(const f32x4*)(ssq_q + row * 8 + 4);
                const float rs = rsqrtf(((p0[0] + p0[1]) + (p0[2] + p0[3]) + (p1[0] + p1[1]) + (p1[2] + p1[3])) * (1.0f / QL) + EPS) * QSCALE;
                bf16_t* qrow = Q + (size_t)row * 768;
#pragma unroll
                for (int bj = 0; bj < 2; ++bj) {
                    const f32x4 v0 = acc[ai][bj][m][0] * rs, v1 = acc[ai][bj][m][1] * rs;
                    if (pn < 2) { *(u32x4*)(qrow + (pn * 2 + bj) * 192 + c8) = pack8(v0, v1); }
                    else { const int head = 2 * bj + (wc >> 1), i0 = 16 * (wc & 1) + 4 * fq; f32x4 lo, hi; rope4(v0, v1, rope + (size_t)row * 64 + 2 * i0, lo, hi);
                        *(u32x2*)(qrow + head * 192 + 128 + i0) = pack4(lo); *(u32x2*)(qrow + head * 192 + 160 + i0) = pack4(hi); }
                }
                asm volatile("" ::: "memory");
            }
    }
};
struct Epi3a {
    static constexpr bool PERM = true, AFTER_DRAIN = false;
    const float* ssq_kv; bf16_t* Kn;
    __device__ __forceinline__ void operator()(const f32x4 (&acc)[2][2][4][2], const Unit& u, int wr, int wc, int fr, int fq) const {
        const int c8 = u.pn * 256 + wc * 32 + 8 * fq;
#pragma unroll
        for (int ai = 0; ai < 2; ++ai)
#pragma unroll
            for (int m = 0; m < 4; ++m) {
                const int row = u.pm * 256 + ai * 128 + wr * 64 + m * 16 + fr;
                const f32x4 p0 = *(const f32x4*)(ssq_kv + row * 4);
                const float rs = rsqrtf(((p0[0] + p0[1]) + (p0[2] + p0[3])) * (1.0f / KVL) + EPS);
#pragma unroll
                for (int bj = 0; bj < 2; ++bj) *(u32x4*)(Kn + (size_t)row * 512 + bj * 128 + c8) = pack8(acc[ai][bj][m][0] * rs, acc[ai][bj][m][1] * rs);
                asm volatile("" ::: "memory");
            }
    }
};
struct Epi3b {
    static constexpr bool PERM = true, AFTER_DRAIN = false;
    const float* ssq_kv; bf16_t* Vt;
    __device__ __forceinline__ void operator()(const f32x4 (&acc)[2][2][4][2], const Unit& u, int wr, int wc, int fr, int fq) const {
        const int t8 = u.pn * 256 + wc * 32 + 8 * fq;
#pragma unroll
        for (int bj = 0; bj < 2; ++bj) {
            f32x4 rs[2];
#pragma unroll
            for (int e = 0; e < 8; ++e) { const f32x4 p0 = *(const f32x4*)(ssq_kv + (size_t)(t8 + bj * 128 + e) * 4);
                rs[e >> 2][e & 3] = rsqrtf(((p0[0] + p0[1]) + (p0[2] + p0[3])) * (1.0f / KVL) + EPS); }
#pragma unroll
            for (int ai = 0; ai < 2; ++ai)
#pragma unroll
                for (int m = 0; m < 4; ++m) {
                    const int hv = u.pm * 256 + ai * 128 + wr * 64 + m * 16 + fr;
                    *(u32x4*)(Vt + (size_t)hv * T + bj * 128 + t8) = pack8(acc[ai][bj][m][0] * rs[0], acc[ai][bj][m][1] * rs[1]);
                }
            asm volatile("" ::: "memory");
        }
    }
};
struct Epi4 {
    static constexpr bool PERM = true, AFTER_DRAIN = false;
    const float* x; float* out; bf16_t* Hb; float* ssq_h;
    __device__ __forceinline__ void operator()(const f32x4 (&acc)[2][2][4][2], const Unit& u, int wr, int wc, int fr, int fq) const {
        const int c8 = u.pn * 256 + wc * 32 + 8 * fq;
#pragma unroll
        for (int ai = 0; ai < 2; ++ai)
#pragma unroll
            for (int m = 0; m < 4; ++m) {
                const int row = u.pm * 256 + ai * 128 + wr * 64 + m * 16 + fr;
                float s = 0.f;
#pragma unroll
                for (int bj = 0; bj < 2; ++bj) { const size_t off = (size_t)row * DM + bj * 128 + c8;
                    const f32x4 h0 = *(const f32x4*)(x + off) + acc[ai][bj][m][0], h1 = *(const f32x4*)(x + off + 4) + acc[ai][bj][m][1];
                    *(f32x4*)(out + off) = h0; *(f32x4*)(out + off + 4) = h1; *(u32x4*)(Hb + off) = pack8(h0, h1); s += dot4(h0) + dot4(h1); }
                s = quad_fq_sum(s);
                if (fq == 0) ssq_h[row * 16 + u.pn * 4 + wc] = s;
                asm volatile("" ::: "memory");
            }
    }
};
struct Epi5 {
    static constexpr bool PERM = true, AFTER_DRAIN = false;
    const float* ssq_h; bf16_t* Act;
    __device__ __forceinline__ void operator()(const f32x4 (&acc)[2][2][4][2], const Unit& u, int wr, int wc, int fr, int fq) const {
        const int c8 = u.pn * 256 + wc * 32 + 8 * fq;
#pragma unroll
        for (int ai = 0; ai < 2; ++ai)
#pragma unroll
            for (int m = 0; m < 4; ++m) {
                const int row = u.pm * 256 + ai * 128 + wr * 64 + m * 16 + fr;
                const f32x4 p0 = *(const f32x4*)(ssq_h + row * 16), p1 = *(const f32x4*)(ssq_h + row * 16 + 4), p2 = *(const f32x4*)(ssq_h + row * 16 + 8), p3 = *(const f32x4*)(ssq_h + row * 16 + 12);
                const f32x4 ps = (p0 + p1) + (p2 + p3);
                const float rs = rsqrtf(((ps[0] + ps[1]) + (ps[2] + ps[3])) * (1.0f / DM) + EPS);
#pragma unroll
                for (int bj = 0; bj < 2; ++bj) { f32x4 v0 = acc[ai][bj][m][0] * rs, v1 = acc[ai][bj][m][1] * rs;
#pragma unroll
                    for (int e = 0; e < 4; ++e) { const float a = fmaxf(v0[e], 0.f), b = fmaxf(v1[e], 0.f); v0[e] = a * a; v1[e] = b * b; }
                    *(u32x4*)(Act + (size_t)row * FF + bj * 128 + c8) = pack8(v0, v1); }
                asm volatile("" ::: "memory");
            }
    }
};
struct Epi6 {
    static constexpr bool PERM = true, AFTER_DRAIN = false;
    const float* hin; float* out; float* ssq_o;
    __device__ __forceinline__ void operator()(const f32x4 (&acc)[2][2][4][2], const Unit& u, int wr, int wc, int fr, int fq) const {
        const int c8 = u.pn * 256 + wc * 32 + 8 * fq;
#pragma unroll
        for (int ai = 0; ai < 2; ++ai)
#pragma unroll
            for (int m = 0; m < 4; ++m) {
                const int row = u.pm * 256 + ai * 128 + wr * 64 + m * 16 + fr;
                float s = 0.f;
#pragma unroll
                for (int bj = 0; bj < 2; ++bj) { const size_t off = (size_t)row * DM + bj * 128 + c8;
                    const f32x4 h0 = *(const f32x4*)(hin + off) + acc[ai][bj][m][0], h1 = *(const f32x4*)(hin + off + 4) + acc[ai][bj][m][1];
                    *(f32x4*)(out + off) = h0; *(f32x4*)(out + off + 4) = h1; s += dot4(h0) + dot4(h1); }
                s = quad_fq_sum(s);
                if (fq == 0) ssq_o[row * 16 + u.pn * 4 + wc] = s;
                asm volatile("" ::: "memory");
            }
    }
};

#define LDS_WAIT() asm volatile("s_waitcnt lgkmcnt(0)" ::: "memory")
template <int MAT>
__device__ __forceinline__ void tr_item(const float* __restrict__ W, int ldw, const float* __restrict__ gain, bf16_t* __restrict__ WT, int ldd, int nblk, LAS float* scr, int item, int lane) {
    const int kb = item / nblk, nb = item % nblk, k0 = 64 * kb, n0 = 32 * nb, gcol = n0 + (lane & 31);
    const int sc = MAT == 0 ? cm_win(gcol) : MAT == 1 ? cm_wq(gcol) : MAT == 2 ? cm_wk(gcol) : MAT == 3 ? cm_wv(gcol) : gcol;
#pragma unroll 8
    for (int i = 0; i < 32; ++i) { const int kk = 2 * i + (lane >> 5); float v = 0.f;
        if (sc >= 0) { v = W[(size_t)(k0 + kk) * ldw + sc]; if (gain) v *= gain[k0 + kk]; }
        scr[kk * 33 + (lane & 31)] = v; }
    LDS_WAIT(); asm volatile("" ::: "memory");
    const int c = lane & 7;
#pragma unroll
    for (int j = 0; j < 4; ++j) { const int n = (lane >> 3) + 8 * j; const LAS float* s = scr + (8 * c) * 33 + n;
        u32x4 o; o.x = cvt_pk_bf16(s[0 * 33], s[1 * 33]); o.y = cvt_pk_bf16(s[2 * 33], s[3 * 33]); o.z = cvt_pk_bf16(s[4 * 33], s[5 * 33]); o.w = cvt_pk_bf16(s[6 * 33], s[7 * 33]);
        *(u32x4*)(WT + (size_t)(n0 + n) * ldd + k0 + 8 * c) = o; }
    LDS_WAIT(); asm volatile("" ::: "memory");
}

constexpr int KN_B = 64 * 256, KR_B = 64 * 128, VT_B = 128 * 128, STG_B = KN_B + KR_B + VT_B;
static_assert(2 * STG_B <= 131072, "attention LDS");

__device__ __forceinline__ void attn_unit(LAS unsigned char* lds, const bf16_t* __restrict__ Q, const bf16_t* __restrict__ Kn, const bf16_t* __restrict__ Kpe,
                                          const bf16_t* __restrict__ Vt, bf16_t* __restrict__ Mix, int b, int h, int qb, int tid, int wid, int lane_in) {
    int lane = lane_in; asm volatile("" : "+v"(lane));
    const int fr = lane & 15, g = lane >> 4;
    const int q0 = qb * 256 + wid * 32;
    const size_t rb = (size_t)b * SEQ;
    bf16x8 qf[2][6];
#pragma unroll
    for (int q2 = 0; q2 < 2; ++q2)
#pragma unroll
        for (int ks = 0; ks < 6; ++ks) qf[q2][ks] = *(const bf16x8*)(Q + (rb + q0 + 16 * q2 + fr) * 768 + h * 192 + 32 * ks + 8 * g);
    f32x4 o[8][2];
#pragma unroll
    for (int vb = 0; vb < 8; ++vb) { o[vb][0] = (f32x4){0.f, 0.f, 0.f, 0.f}; o[vb][1] = (f32x4){0.f, 0.f, 0.f, 0.f}; }
    float mrun[2] = {-INFINITY, -INFINITY}, lrun[2] = {0.f, 0.f};
    const int nt = 4 * (qb + 1);
    unsigned oN[2], oV[2], oR;
#pragma unroll
    for (int r = 0; r < 2; ++r) { const int L = (r * 8 + wid) * 64 + lane;
        { const int key = L >> 4, pc = L & 15, cc = pc ^ (key & 15); oN[r] = (unsigned)(key * 1024 + cc * 16); }
        { const int vd = L >> 3, pc = L & 7, cc = pc ^ ((vd >> 1) & 7); oV[r] = (unsigned)(vd * (T * 2) + cc * 16); } }
    { const int L = wid * 64 + lane, key = L >> 3, pc = L & 7, cc = pc ^ ((key >> 1) & 7); oR = (unsigned)(key * 128 + cc * 16); }
    const char* bN = (const char*)(Kn + rb * 512 + h * 128); const char* bR = (const char*)(Kpe + rb * 64); const char* bV = (const char*)(Vt + (size_t)(h * 128) * T + rb);
#define ATT_DMA(kt, buf) do { LAS unsigned char* _d = lds + (buf) * STG_B; const char* _n = bN + (size_t)(kt) * (64 * 512 * 2); const char* _r = bR + (size_t)(kt) * (64 * 64 * 2); const char* _v = bV + (size_t)(kt) * 128; \
        __builtin_amdgcn_global_load_lds((const unsigned*)(_n + oN[0]), (LAS unsigned*)(_d + wid * 1024), 16, 0, 0); \
        __builtin_amdgcn_global_load_lds((const unsigned*)(_n + oN[1]), (LAS unsigned*)(_d + 8192 + wid * 1024), 16, 0, 0); \
        __builtin_amdgcn_global_load_lds((const unsigned*)(_r + oR), (LAS unsigned*)(_d + KN_B + wid * 1024), 16, 0, 0); \
        __builtin_amdgcn_global_load_lds((const unsigned*)(_v + oV[0]), (LAS unsigned*)(_d + KN_B + KR_B + wid * 1024), 16, 0, 0); \
        __builtin_amdgcn_global_load_lds((const unsigned*)(_v + oV[1]), (LAS unsigned*)(_d + KN_B + KR_B + 8192 + wid * 1024), 16, 0, 0); } while (0)
    const int swr = (fr >> 1) & 7;
    const int aN = fr * 256 + ((g ^ fr) << 4);
    const int aR = KN_B + fr * 128 + ((g ^ swr) << 4);
    const int aV = KN_B + KR_B + fr * 128 + (((g >> 1) ^ swr) << 4) + (g & 1) * 8;
    ATT_DMA(0, 0);
    asm volatile("s_waitcnt vmcnt(0)" ::: "memory");
    __syncthreads();
    for (int kt = 0; kt < nt; ++kt) {
        const int buf = kt & 1;
        if (kt + 1 < nt) ATT_DMA(kt + 1, buf ^ 1);
        if (kt * 64 <= q0 + 31) {
            LAS unsigned char* Sb = lds + buf * STG_B;
            f32x4 s[4][2];
#pragma unroll
            for (int kb = 0; kb < 4; ++kb) { s[kb][0] = (f32x4){0.f, 0.f, 0.f, 0.f}; s[kb][1] = (f32x4){0.f, 0.f, 0.f, 0.f}; }
#pragma unroll
            for (int ks = 0; ks < 6; ++ks) {
                bf16x8 kf[4];
#pragma unroll
                for (int kb = 0; kb < 4; ++kb) kf[kb] = (ks < 4) ? *(const LAS bf16x8*)(Sb + (aN ^ (ks * 64)) + kb * 4096) : *(const LAS bf16x8*)(Sb + (aR ^ ((ks - 4) * 64)) + kb * 2048);
#pragma unroll
                for (int kb = 0; kb < 4; ++kb) {
                    s[kb][0] = __builtin_amdgcn_mfma_f32_16x16x32_bf16(kf[kb], qf[0][ks], s[kb][0], 0, 0, 0);
                    s[kb][1] = __builtin_amdgcn_mfma_f32_16x16x32_bf16(kf[kb], qf[1][ks], s[kb][1], 0, 0, 0); }
            }
            if (kt * 64 + 63 > q0) {
#pragma unroll
                for (int q2 = 0; q2 < 2; ++q2) { const int qi = q0 + 16 * q2 + fr;
#pragma unroll
                    for (int kb = 0; kb < 4; ++kb)
#pragma unroll
                        for (int i = 0; i < 4; ++i) if (kt * 64 + 16 * kb + 4 * g + i > qi) s[kb][q2][i] = -INFINITY; }
            }
            bf16x8 pb[2][2];
#pragma unroll
            for (int q2 = 0; q2 < 2; ++q2) {
                float mx = fmaxf(fmaxf(s[0][q2][0], s[0][q2][1]), fmaxf(s[0][q2][2], s[0][q2][3]));
#pragma unroll
                for (int kb = 1; kb < 4; ++kb) mx = fmaxf(mx, fmaxf(fmaxf(s[kb][q2][0], s[kb][q2][1]), fmaxf(s[kb][q2][2], s[kb][q2][3])));
                mx = fmaxf(mx, __shfl_xor(mx, 16)); mx = fmaxf(mx, __shfl_xor(mx, 32));
                const float mnew = fmaxf(mrun[q2], mx), alpha = __builtin_amdgcn_exp2f(mrun[q2] - mnew);
                mrun[q2] = mnew;
                float rsum = 0.f;
#pragma unroll
                for (int kb = 0; kb < 4; ++kb)
#pragma unroll
                    for (int i = 0; i < 4; ++i) { const float p = __builtin_amdgcn_exp2f(s[kb][q2][i] - mnew); s[kb][q2][i] = p; rsum += p; }
                lrun[q2] = lrun[q2] * alpha + rsum;
#pragma unroll
                for (int vb = 0; vb < 8; ++vb) o[vb][q2] = o[vb][q2] * alpha;
#pragma unroll
                for (int k2 = 0; k2 < 2; ++k2) { const u32x4 w = pack8(s[2 * k2][q2], s[2 * k2 + 1][q2]); pb[q2][k2] = __builtin_bit_cast(bf16x8, w); }
            }
#pragma unroll
            for (int k2 = 0; k2 < 2; ++k2)
#pragma unroll
                for (int vq = 0; vq < 2; ++vq) {
                    bf16x8 vf[4];
#pragma unroll
                    for (int v4 = 0; v4 < 4; ++v4) { const LAS unsigned char* vp = Sb + (aV ^ (k2 * 64)) + (4 * vq + v4) * 2048; const LAS unsigned char* vph = Sb + (aV ^ (k2 * 64) ^ 32) + (4 * vq + v4) * 2048;
                        const s16x4 lo = *(const LAS s16x4*)vp, hi = *(const LAS s16x4*)vph;
                        vf[v4] = (bf16x8){lo[0], lo[1], lo[2], lo[3], hi[0], hi[1], hi[2], hi[3]}; }
#pragma unroll
                    for (int v4 = 0; v4 < 4; ++v4) {
                        o[4 * vq + v4][0] = __builtin_amdgcn_mfma_f32_16x16x32_bf16(vf[v4], pb[0][k2], o[4 * vq + v4][0], 0, 0, 0);
                        o[4 * vq + v4][1] = __builtin_amdgcn_mfma_f32_16x16x32_bf16(vf[v4], pb[1][k2], o[4 * vq + v4][1], 0, 0, 0); }
                }
        }
        asm volatile("s_waitcnt vmcnt(0)" ::: "memory");
        __syncthreads();
    }
#undef ATT_DMA
#pragma unroll
    for (int q2 = 0; q2 < 2; ++q2) {
        const float l = quad_fq_sum(lrun[q2]), inv = 1.0f / l;
        bf16_t* orow = Mix + (rb + q0 + 16 * q2 + fr) * DM + h * 128 + 4 * g;
#pragma unroll
        for (int vb = 0; vb < 8; ++vb) *(u32x2*)(orow + 16 * vb) = pack4(o[vb][q2] * inv);
    }
}

#define XB_TMO      128
#define XB_XCNT(j)  (256  + 64 * (j))
#define XB_XSUB(j)  (1280 + 64 * (j))
#define XB_XGEN(j)  (2304 + 64 * (j))
#define XB_TOP      3328
#define XB_TOPGEN   3392
#define XCD_BAR_WORDS 3456
#define XB_SPIN_CAP (1u << 18)

__device__ __forceinline__ unsigned xb_ld(unsigned* p)              { return __hip_atomic_load(p, __ATOMIC_RELAXED, __HIP_MEMORY_SCOPE_AGENT); }
__device__ __forceinline__ unsigned xb_add(unsigned* p, unsigned v) { return __hip_atomic_fetch_add(p, v, __ATOMIC_RELAXED, __HIP_MEMORY_SCOPE_AGENT); }
__device__ __forceinline__ unsigned xb_xcc_id() { return (unsigned)__builtin_amdgcn_s_getreg((3 << 11) | 20) & 0xFu; }
#define XB_SPIN(cond, bar) do { unsigned _sp = 0; while (cond) { __builtin_amdgcn_s_sleep(1); \
    if ((++_sp & 255u) == 0u) { if (xb_ld(&(bar)[XB_TMO])) break; if (_sp > XB_SPIN_CAP) { atomicAdd(&(bar)[XB_TMO], 1u); break; } } } } while (0)

struct XcdBarrier {
    unsigned* bar; unsigned x;
    volatile LAS unsigned* st;
};

__device__ __forceinline__ XcdBarrier xcd_barrier_post(unsigned* bar, volatile LAS unsigned* st) {
    XcdBarrier b; b.bar = bar; b.x = xb_xcc_id(); b.st = st;
    if (threadIdx.x == 0) (void)xb_add(&bar[XB_XCNT(b.x)], 1u);
    return b;
}
__device__ __forceinline__ void xcd_barrier_complete(unsigned* bar, unsigned x, unsigned& nloc, unsigned& nx) {
    const unsigned G = gridDim.x * gridDim.y * gridDim.z;
    unsigned sum, cnt, mine, sp = 0u;
    for (;;) {
        sum = 0u; cnt = 0u; mine = 0u;
#pragma unroll
        for (unsigned j = 0; j < 16; ++j) { const unsigned c = xb_ld(&bar[XB_XCNT(j)]); sum += c; cnt += (c > 0u) ? 1u : 0u; mine = (j == x) ? c : mine; }
        if (sum == G) break;
        __builtin_amdgcn_s_sleep(1);
        if ((++sp & 255u) == 0u) { if (xb_ld(&bar[XB_TMO])) break; if (sp > XB_SPIN_CAP) { atomicAdd(&bar[XB_TMO], 1u); break; } }
    }
    nloc = mine > 0u ? mine : 1u; nx = cnt > 0u ? cnt : 1u;
}

__device__ __forceinline__ void xcd_barrier(const XcdBarrier& b) {
    asm volatile("s_waitcnt vmcnt(0)" ::: "memory");
    __syncthreads();
    if (threadIdx.x == 0) {
        unsigned* bar = b.bar;
        __builtin_amdgcn_s_waitcnt(0);
        unsigned nloc = b.st[0], nx = b.st[1];
        if (nloc == 0u) { xcd_barrier_complete(bar, b.x, nloc, nx); b.st[0] = nloc; b.st[1] = nx; }
        const unsigned old = xb_add(&bar[XB_XSUB(b.x)], 1u);
        const unsigned gen = old / nloc;
        if (old + 1u == (gen + 1u) * nloc) {
            __builtin_amdgcn_fence(__ATOMIC_RELEASE, "agent");
            asm volatile("s_waitcnt vmcnt(0)" ::: "memory");
            const unsigned og = xb_add(&bar[XB_TOP], 1u);
            const unsigned tg = og / nx;
            if (og + 1u == (tg + 1u) * nx) xb_add(&bar[XB_TOPGEN], 1u);
            else XB_SPIN(xb_ld(&bar[XB_TOPGEN]) == tg, bar);
            __builtin_amdgcn_fence(__ATOMIC_ACQUIRE, "agent");
            xb_add(&bar[XB_XGEN(b.x)], 1u);
            asm volatile("s_waitcnt vmcnt(0)" ::: "memory");
        } else {
            XB_SPIN(xb_ld(&bar[XB_XGEN(b.x)]) == gen, bar);
            __builtin_amdgcn_fence(__ATOMIC_ACQUIRE, "agent");
            asm volatile("s_waitcnt vmcnt(0)" ::: "memory");
        }
    }
    __syncthreads();
}

#ifndef REPMASK
#define REPMASK 0
#endif
struct Args { const float* in[15]; float* out; unsigned char* ws; };
__global__ void __launch_bounds__(NTHR, 2) mk_fwd(Args a) {
    extern __shared__ __attribute__((aligned(16))) unsigned char lds_raw[];
    LAS unsigned char* lds = (LAS unsigned char*)lds_raw;
    cg::grid_group grid = cg::this_grid();
    const int tid = threadIdx.x, lane = tid & 63, wid = __builtin_amdgcn_readfirstlane(tid >> 6);
    const int G = gridDim.x, bx = blockIdx.x, vcu = (G % 8 == 0) ? (bx % 8) * (G / 8) + bx / 8 : bx;
    const int gw = vcu * NWAVES + wid, NGW = G * NWAVES, gtid = bx * NTHR + tid, NT = G * NTHR;
    unsigned char* ws = a.ws;
    volatile LAS unsigned* MISC = (volatile LAS unsigned*)(lds + 131072);
    if (tid < 64) MISC[tid] = 0u;
    __syncthreads();
    XcdBarrier xbar = xcd_barrier_post((unsigned*)(ws + WS_CTL), MISC + 8);
    const float* x = a.in[0]; const int* pos = (const int*)a.in[1]; const float* g_mix = a.in[2]; const float* w_in = a.in[3]; const float* g_q = a.in[4]; const float* w_q = a.in[5];
    const float* g_kv = a.in[6]; const float* w_kv = a.in[7]; const float* pool_w = a.in[8]; const float* pool_s = a.in[9]; const float* w_out = a.in[10]; const float* g_mlp = a.in[11];
    const float* w_up = a.in[12]; const float* w_dn = a.in[13]; const float* g_fin = a.in[14]; float* out = a.out;
    bf16_t* Win_t = (bf16_t*)(ws + WS_WIN); bf16_t* Wq_t = (bf16_t*)(ws + WS_WQ); bf16_t* Wk_t = (bf16_t*)(ws + WS_WK); bf16_t* Wv_t = (bf16_t*)(ws + WS_WV); bf16_t* Wo_t = (bf16_t*)(ws + WS_WO);
    bf16_t* Wup_t = (bf16_t*)(ws + WS_WUP); bf16_t* Wdn_t = (bf16_t*)(ws + WS_WDN);
    float* rope = (float*)(ws + WS_ROPE); float* rstd_x = (float*)(ws + WS_RSTDX); float* ssq_kv = (float*)(ws + WS_SSQKV); float* ssq_q = (float*)(ws + WS_SSQQ);
    float* ssq_h = (float*)(ws + WS_SSQH); float* ssq_o = (float*)(ws + WS_SSQO);
    bf16_t* Hb = (bf16_t*)(ws + WS_HB); bf16_t* Xb = (bf16_t*)(ws + WS_XB); bf16_t* Cq = (bf16_t*)(ws + WS_CQ); bf16_t* Ckv = (bf16_t*)(ws + WS_CKV); bf16_t* Kpe = (bf16_t*)(ws + WS_KPE);
    bf16_t* U = (bf16_t*)(ws + WS_U); bf16_t* Qb = (bf16_t*)(ws + WS_Q); bf16_t* Kn = (bf16_t*)(ws + WS_KN); bf16_t* Vt = (bf16_t*)(ws + WS_VT); bf16_t* Mix = (bf16_t*)(ws + WS_MIX);
    bf16_t* Act = (bf16_t*)(ws + WS_ACT); float* H2 = (float*)(ws + WS_H2);

    for (int rep_ = 0; rep_ <= ((REPMASK >> 0) & 1); ++rep_) {
    {
        LAS float* scr = (LAS float*)(lds + wid * 16384);
        constexpr int I_IN = 16 * (N1 / 32), I_Q = 6 * 24, I_K = 4 * 16, I_V = 4 * 16, I_O = 8 * 32, I_UP = 16 * 128, I_DN = 64 * 32;
        constexpr int NITEMS = I_IN + I_Q + I_K + I_V + I_O + I_UP + I_DN;
        for (int it = gw; it < NITEMS; it += NGW) {
            int r = it;
            if (r < I_UP) { tr_item<4>(w_up, FF, g_mlp, Wup_t, DM, FF / 32, scr, r, lane); continue; } r -= I_UP;
            if (r < I_DN) { tr_item<4>(w_dn, DM, nullptr, Wdn_t, FF, DM / 32, scr, r, lane); continue; } r -= I_DN;
            if (r < I_IN) { tr_item<0>(w_in, INW, g_mix, Win_t, DM, N1 / 32, scr, r, lane); continue; } r -= I_IN;
            if (r < I_Q) { tr_item<1>(w_q, 768, g_q, Wq_t, QL, 24, scr, r, lane); continue; } r -= I_Q;
            if (r < I_K) { tr_item<2>(w_kv, 1024, g_kv, Wk_t, KVL, 16, scr, r, lane); continue; } r -= I_K;
            if (r < I_V) { tr_item<3>(w_kv, 1024, g_kv, Wv_t, KVL, 16, scr, r, lane); continue; } r -= I_V;
            tr_item<4>(w_out, DM, nullptr, Wo_t, DM, 32, scr, r, lane);
        }
        for (int it = gtid; it < 65536; it += NT) {
            const int n = it & 1023, c8 = (it >> 10) & 15, gg = it >> 14;
            float accv[8];
#pragma unroll
            for (int cc = 0; cc < 8; ++cc) accv[cc] = 0.f;
            const float* pw = pool_w + (size_t)(gg * 128 + c8 * 8) * 128;
            for (int d = 0; d < 128; ++d) { const float wv = w_out[(size_t)(512 + gg * 128 + d) * DM + n] * pool_s[gg * 128 + d];
#pragma unroll
                for (int cc = 0; cc < 8; ++cc) accv[cc] += pw[cc * 128 + d] * wv; }
            u32x4 o; o.x = cvt_pk_bf16(accv[0], accv[1]); o.y = cvt_pk_bf16(accv[2], accv[3]); o.z = cvt_pk_bf16(accv[4], accv[5]); o.w = cvt_pk_bf16(accv[6], accv[7]);
            *(u32x4*)(Wo_t + (size_t)n * DM + 512 + gg * 128 + c8 * 8) = o;
        }
        for (int it = gtid; it < T * 32; it += NT) {
            const int row = it >> 5, i = it & 31;
            const float inv = exp2f(-(float)i * (13.287712379549449f / 32.0f));
            const float ang = (float)pos[row] * inv;
            double rev = (double)ang * 0.15915494309189535; rev -= rint(rev);
            const float fr_ = (float)rev;
            rope[2 * it] = __builtin_amdgcn_cosf(fr_); rope[2 * it + 1] = __builtin_amdgcn_sinf(fr_);
        }
        for (int row = gw; row < T; row += NGW) {
            const f32x4* xr = (const f32x4*)(x + (size_t)row * DM) + lane;
            f32x4 v[4]; float s = 0.f;
#pragma unroll
            for (int j = 0; j < 4; ++j) { v[j] = xr[64 * j]; s += dot4(v[j]); }
            s = wave_sum(s);
            if (lane == 0) rstd_x[row] = rsqrtf(s * (1.0f / DM) + EPS);
            u32x2* o8 = (u32x2*)(Xb + (size_t)row * DM) + lane;
#pragma unroll
            for (int j = 0; j < 4; ++j) o8[64 * j] = pack4(v[j]);
        }
    }
    }
    grid.sync();
    for (int rep_ = 0; rep_ <= ((REPMASK >> 1) & 1); ++rep_) {
    {
        pg8::Gemm g{Xb, Win_t, T, N1, DM}; pg8::StaticOrder S; S.init(T, N1, G, bx);
        Epi1 E{rstd_x, rope, Ckv, Cq, Kpe, U, ssq_kv, ssq_q};
        pg8::gemm_phase<Epi1, pg8::StaticOrder, true, true>(lds, g, S, E);
    }
    }
    xcd_barrier(xbar);
    for (int rep_ = 0; rep_ <= ((REPMASK >> 2) & 1); ++rep_) {
    {
        for (int it = gtid; it < T * 64; it += NT) {
            const int row = it >> 6, c8 = it & 63, gg = c8 >> 4, w = 2 << gg, sidx = row & (SEQ - 1), cnt = (sidx + 1 < w) ? sidx + 1 : w;
            float sum[8], cur[8];
            { const u32x4 r0 = *(const u32x4*)(U + (size_t)row * PW + c8 * 8);
#pragma unroll
              for (int e = 0; e < 4; ++e) { cur[2 * e] = __uint_as_float(r0[e] << 16); cur[2 * e + 1] = __uint_as_float(r0[e] & 0xffff0000u); sum[2 * e] = cur[2 * e]; sum[2 * e + 1] = cur[2 * e + 1]; } }
            for (int j = 1; j < cnt; ++j) { const u32x4 r0 = *(const u32x4*)(U + (size_t)(row - j) * PW + c8 * 8);
#pragma unroll
                for (int e = 0; e < 4; ++e) { sum[2 * e] += __uint_as_float(r0[e] << 16); sum[2 * e + 1] += __uint_as_float(r0[e] & 0xffff0000u); } }
            const float ic = 1.0f / (float)cnt;
            u32x4 o;
#pragma unroll
            for (int e = 0; e < 4; ++e) o[e] = cvt_pk_bf16(sum[2 * e] * ic - cur[2 * e], sum[2 * e + 1] * ic - cur[2 * e + 1]);
            *(u32x4*)(Mix + (size_t)row * DM + 512 + c8 * 8) = o;
        }
        { pg8::Gemm g{Cq, Wq_t, T, 768, QL}; pg8::StaticOrder S; S.init(T, 768, G, bx); Epi2 E{ssq_q, rope, Qb};
          pg8::gemm_phase<Epi2, pg8::StaticOrder, true, true>(lds, g, S, E); }
        { pg8::Gemm g{Ckv, Wk_t, T, 512, KVL}; pg8::StaticOrder S; S.init(T, 512, G, bx); Epi3a E{ssq_kv, Kn};
          pg8::gemm_phase<Epi3a, pg8::StaticOrder, true, true>(lds, g, S, E); }
        { pg8::Gemm g{Wv_t, Ckv, 512, T, KVL}; pg8::StaticOrder S; S.init(512, T, G, bx); Epi3b E{ssq_kv, Vt};
          pg8::gemm_phase<Epi3b, pg8::StaticOrder, true, true>(lds, g, S, E); }
    }
    }
    xcd_barrier(xbar);
    for (int rep_ = 0; rep_ <= ((REPMASK >> 3) & 1); ++rep_) {
    for (int p = vcu; p < 256; p += G) {
        const int bh = p >> 2, pi = p & 3, b = bh >> 2, h = bh & 3;
        attn_unit(lds, Qb, Kn, Kpe, Vt, Mix, b, h, 7 - pi, tid, wid, lane);
        attn_unit(lds, Qb, Kn, Kpe, Vt, Mix, b, h, pi, tid, wid, lane);
    }
    }
    xcd_barrier(xbar);
    for (int rep_ = 0; rep_ <= ((REPMASK >> 4) & 1); ++rep_) {
    {
        pg8::Gemm g{Mix, Wo_t, T, DM, DM}; pg8::StaticOrder S; S.init(T, DM, G, bx); Epi4 E{x, out, Hb, ssq_h};
        pg8::gemm_phase<Epi4, pg8::StaticOrder, true, true>(lds, g, S, E);
    }
    }
    xcd_barrier(xbar);
    for (int rep_ = 0; rep_ <= ((REPMASK >> 5) & 1); ++rep_) {
    {
        pg8::Gemm g{Hb, Wup_t, T, FF, DM}; pg8::StaticOrder S; S.init(T, FF, G, bx); Epi5 E{ssq_h, Act};
        pg8::gemm_phase<Epi5, pg8::StaticOrder, true, true>(lds, g, S, E);
    }
    }
    xcd_barrier(xbar);
    for (int rep_ = 0; rep_ <= ((REPMASK >> 6) & 1); ++rep_) {
    {
        pg8::Gemm g{Act, Wdn_t, T, DM, FF}; pg8::StaticOrder S; S.init(T, DM, G, bx); Epi6 E{out, H2, ssq_o};
        pg8::gemm_phase<Epi6, pg8::StaticOrder, true, true>(lds, g, S, E);
    }
    }
    xcd_barrier(xbar);
    for (int rep_ = 0; rep_ <= ((REPMASK >> 7) & 1); ++rep_) {
#ifdef XSYNC
    for (int xs_ = 0; xs_ < XSYNC; ++xs_) xcd_barrier(xbar);
#endif
    for (int row = gw; row < T; row += NGW) {
        float s = ssq_o[row * 16 + (lane & 15)];
        s += __shfl_xor(s, 1); s += __shfl_xor(s, 2); s += __shfl_xor(s, 4); s += __shfl_xor(s, 8);
        const float rs = rsqrtf(s * (1.0f / DM) + EPS);
        f32x4* orow = (f32x4*)(out + (size_t)row * DM) + lane; const f32x4* hrow = (const f32x4*)(H2 + (size_t)row * DM) + lane; const f32x4* gr = (const f32x4*)g_fin + lane;
#pragma unroll
        for (int j = 0; j < 4; ++j) orow[64 * j] = hrow[64 * j] * rs * gr[64 * j];
    }
    }
}

extern "C" void kernel_launch(void* const* d_in, const int* in_sizes, int n_in, void* d_out, int out_size, void* d_ws, size_t ws_size, hipStream_t stream) {
    static int grid = 0;
    if (grid == 0) {
        if (n_in != 15 || in_sizes[0] != T * DM || out_size != T * DM || ws_size < WS_END) { fprintf(stderr, "kernel_launch: unexpected shapes (n_in %d, in0 %d, out %d, ws %zu); nothing launched\n", n_in, n_in > 0 ? in_sizes[0] : -1, out_size, ws_size); grid = -1; return; }
        int dev = 0, cus = 0, per_cu = 0;
        if (hipGetDevice(&dev) != hipSuccess || hipDeviceGetAttribute(&cus, hipDeviceAttributeMultiprocessorCount, dev) != hipSuccess) { grid = -1; return; }
        if (hipFuncSetAttribute((const void*)mk_fwd, hipFuncAttributeMaxDynamicSharedMemorySize, LDS_BYTES) != hipSuccess) { fprintf(stderr, "kernel_launch: hipFuncSetAttribute failed\n"); grid = -1; return; }
        if (hipOccupancyMaxActiveBlocksPerMultiprocessor(&per_cu, (const void*)mk_fwd, NTHR, LDS_BYTES) != hipSuccess || per_cu < 1) per_cu = 1;
        (void)hipGetLastError();
        grid = cus * per_cu;
    }
    if (grid < 0) return;
    if (hipMemsetAsync((char*)d_ws + WS_CTL, 0, CTL_BYTES, stream) != hipSuccess) { fprintf(stderr, "kernel_launch: memset of the barrier words failed\n"); return; }
    Args a{};
    for (int i = 0; i < 15; ++i) a.in[i] = (const float*)d_in[i];
    a.out = (float*)d_out; a.ws = (unsigned char*)d_ws;
    void* args[] = {&a};
    const hipError_t e = hipLaunchCooperativeKernel((const void*)mk_fwd, dim3(grid), dim3(NTHR), args, LDS_BYTES, stream);
    if (e != hipSuccess) fprintf(stderr, "kernel_launch: cooperative launch failed: %s (grid %d)\n", hipGetErrorString(e), grid);
}
```

```cpp
#include <hip/hip_runtime.h>
#include <hip/hip_cooperative_groups.h>
#include <cstdio>
#include <cstdint>
namespace cg = cooperative_groups;
namespace pg8 {
#define PG8_LAS __attribute__((address_space(3)))
typedef unsigned short bf16_t;
typedef short bf16x8 __attribute__((ext_vector_type(8)));
typedef float f32x4 __attribute__((ext_vector_type(4)));
typedef unsigned u32x4 __attribute__((ext_vector_type(4)));
constexpr int BM = 256, BK = 64, HALF = 128, HTB = HALF * BK * 2  , STAGE_BYTES = 8 * HTB, NXCD = 8, WGM = 8;

__host__ __device__ __forceinline__ int lds_byte(int r, int c) { const int st = (r >> 4) * 2 + (c >> 5), rr = r & 15, cc = c & 31, ob = rr * 64 + cc * 2; return st * 1024 + (ob ^ (((ob >> 9) & 1) << 5)); }
__host__ __device__ __forceinline__ void stage_rc(int b, int& R, int& C) { const int st = b / 1024, sb = b % 1024, swz = sb ^ (((sb >> 9) & 1) << 5); R = (st >> 1) * 16 + swz / 64; C = (st & 1) * 32 + (swz % 64) / 2; }
__host__ __device__ __forceinline__ int perm32(int rho) { const int n = rho >> 4, i = rho & 15; return 8 * (i >> 2) + 4 * n + (i & 3); }

struct Unit { int pm, pn; };
struct Gemm { const bf16_t* A; const bf16_t* Bt; int M, N, K; };

struct StaticOrder {
    int nM, nN, nwg, G, c;
    __host__ __device__ void init(int M, int N, int G_, int c_) { nM = M / BM; nN = N / BM; nwg = nM * nN; G = G_; c = c_; }
    __host__ __device__ bool next(int i, Unit& u) const {
        const long L = (long)i * G + c; if (L >= nwg) return false;
        int wgid = (int)L; { const int q = nwg / NXCD, r = nwg % NXCD, xcd = wgid % NXCD, off = wgid / NXCD; wgid = (xcd < r ? xcd * (q + 1) : r * (q + 1) + (xcd - r) * q) + off; }
        const int nig = WGM * nN, gid = wgid / nig, fm = gid * WGM, gsz = (nM - fm) < WGM ? (nM - fm) : WGM;
        u.pm = fm + ((wgid % nig) % gsz); u.pn = (wgid % nig) / gsz; return true;
    }
    __device__ __forceinline__ void a_ready(const Unit&) const {}
    __device__ __forceinline__ void done(const Unit&) const {}
};

__device__ __forceinline__ unsigned cvt_pk_bf16(float lo, float hi) { unsigned r; asm volatile("v_cvt_pk_bf16_f32 %0, %1, %2" : "=v"(r) : "v"(lo), "v"(hi)); return r; }
typedef float f32x2 __attribute__((ext_vector_type(2)));
template <class Epi, class Sched, bool ALIGN_EPI = false, bool SP2 = false>
__device__ __forceinline__ void gemm_phase(PG8_LAS unsigned char* lds, const Gemm g, const Sched& S, const Epi& E) {
    int tid_l = threadIdx.x; asm volatile("" : "+v"(tid_l));
    const int tid = tid_l, wid = __builtin_amdgcn_readfirstlane(tid >> 6), lane = tid & 63, wr = wid >> 2, wc = wid & 3, fr = lane & 15, fq = lane >> 4;
    const int K = g.K, nt = K / BK;
    unsigned voffA[2], voffB[2];
#pragma unroll
    for (int i = 0; i < 2; ++i) { int R, C; stage_rc(tid * 16 + i * 8192, R, C); const int Rb = Epi::PERM ? ((R & ~31) + perm32(R & 31)) : R;
        voffA[i] = (unsigned)(R * K + C) * 2u; voffB[i] = (unsigned)(Rb * K + C) * 2u; }
    const size_t kstep = (size_t)(BK * 2);
    const size_t hstep = (size_t)HALF * K * 2;
    const size_t tstep = 2 * hstep;
    const unsigned ldsw = (unsigned)wid * 1024u;
    const int aoff = lds_byte(wr * 64 + fr, fq * 8), boff = lds_byte(wc * 32 + fr, fq * 8);
#define PG8_SA(b, h) (((b) * 2 + (h)) * HTB)
#define PG8_SB(b, h) ((4 + (b) * 2 + (h)) * HTB)
#define PG8_STAGE(bufoff, gbase, voff) do { _Pragma("unroll") for (int _i = 0; _i < 2; ++_i) \
        __builtin_amdgcn_global_load_lds((const unsigned*)((const char*)(gbase) + (voff)[_i]), (PG8_LAS unsigned*)(lds + (bufoff) + ldsw + _i * 8192), 16, 0, 0); } while (0)
#define PG8_LDA(dst, b, h) do { _Pragma("unroll") for (int m = 0; m < 4; ++m) _Pragma("unroll") for (int k = 0; k < 2; ++k) dst[m][k] = *(const PG8_LAS bf16x8*)(lds + PG8_SA(b, h) + aoff + m * 2048 + k * 1024); } while (0)
#define PG8_LDB(dst, b, h) do { _Pragma("unroll") for (int n = 0; n < 2; ++n) _Pragma("unroll") for (int k = 0; k < 2; ++k) dst[n][k] = *(const PG8_LAS bf16x8*)(lds + PG8_SB(b, h) + boff + n * 2048 + k * 1024); } while (0)
#define PG8_MMA(ai, bj, At, Bt) do { __builtin_amdgcn_s_setprio(1); _Pragma("unroll") for (int m = 0; m < 4; ++m) _Pragma("unroll") for (int n = 0; n < 2; ++n) _Pragma("unroll") for (int k = 0; k < 2; ++k) \
        acc[ai][bj][m][n] = __builtin_amdgcn_mfma_f32_16x16x32_bf16(Bt[n][k], At[m][k], acc[ai][bj][m][n], 0, 0, 0); __builtin_amdgcn_s_setprio(0); } while (0)
#define PG8_WAIT_V(n) asm volatile("s_waitcnt vmcnt(" #n ")" ::: "memory")
#define PG8_WAIT_L(n) asm volatile("s_waitcnt lgkmcnt(" #n ")" ::: "memory")
#define PG8_BAR __builtin_amdgcn_s_barrier()
#define PG8_SCHED __builtin_amdgcn_sched_barrier(0)
    Unit cur, nxt; int ui = 0;
    if (!S.next(0, cur)) return;
    f32x4 acc[2][2][4][2];
#pragma unroll
    for (int a = 0; a < 2; ++a)
#pragma unroll
        for (int b = 0; b < 2; ++b)
#pragma unroll
            for (int m = 0; m < 4; ++m)
#pragma unroll
                for (int n = 0; n < 2; ++n) acc[a][b][m][n] = (f32x4){0.f, 0.f, 0.f, 0.f};
    bf16x8 At[4][2], B0[2][2], B1[2][2];
    const char* cA = (const char*)g.A + (size_t)cur.pm * tstep; const char* cB = (const char*)g.Bt + (size_t)cur.pn * tstep;
    S.a_ready(cur);
    if constexpr (SP2) {
        PG8_STAGE(PG8_SB(0, 0), cB, voffB); PG8_STAGE(PG8_SB(0, 1), cB + hstep, voffB); PG8_STAGE(PG8_SA(0, 0), cA, voffA); PG8_STAGE(PG8_SA(0, 1), cA + hstep, voffA);
        if (wr == 1) PG8_BAR;
        PG8_WAIT_V(2); PG8_BAR;
        PG8_STAGE(PG8_SB(1, 0), cB + kstep, voffB); PG8_STAGE(PG8_SA(1, 0), cA + kstep, voffA); PG8_STAGE(PG8_SB(1, 1), cB + hstep + kstep, voffB);
        PG8_WAIT_V(6); PG8_BAR;
    } else {
        PG8_STAGE(PG8_SB(0, 0), cB, voffB); PG8_STAGE(PG8_SA(0, 0), cA, voffA); PG8_STAGE(PG8_SB(0, 1), cB + hstep, voffB); PG8_STAGE(PG8_SA(0, 1), cA + hstep, voffA);
        if (wr == 1) PG8_BAR;
        PG8_WAIT_V(4); PG8_BAR;
        PG8_STAGE(PG8_SB(1, 0), cB + kstep, voffB); PG8_STAGE(PG8_SA(1, 0), cA + kstep, voffA); PG8_STAGE(PG8_SB(1, 1), cB + hstep + kstep, voffB);
        PG8_WAIT_V(6); PG8_BAR;
    }
    for (;;) {
        const bool has_next = S.next(ui + 1, nxt);
        const char* nA = has_next ? (const char*)g.A + (size_t)nxt.pm * tstep : cA; const char* nB = has_next ? (const char*)g.Bt + (size_t)nxt.pn * tstep : cB;
#pragma unroll 1
        for (int t = 0; t < nt; t += 2) {
            const bool last = (t == nt - 2);
            const char* a1 = cA + (size_t)(t + 1) * kstep;
            const char* a2 = last ? nA : cA + (size_t)(t + 2) * kstep; const char* b2 = last ? nB : cB + (size_t)(t + 2) * kstep;
            const char* a3 = a2 + kstep; const char* b3 = b2 + kstep;
            if (last && has_next) S.a_ready(nxt);
            if constexpr (SP2) {
            PG8_LDB(B0, 0, 0); PG8_LDB(B1, 0, 1); PG8_SCHED; PG8_LDA(At, 0, 0); PG8_STAGE(PG8_SA(1, 1), a1 + hstep, voffA);
            PG8_WAIT_V(8); PG8_WAIT_L(0); PG8_BAR; PG8_MMA(0, 0, At, B0); PG8_MMA(0, 1, At, B1); PG8_BAR; PG8_SCHED;
            PG8_LDA(At, 0, 1); PG8_STAGE(PG8_SB(0, 0), b2, voffB); PG8_STAGE(PG8_SB(0, 1), b2 + hstep, voffB); PG8_STAGE(PG8_SA(0, 0), a2, voffA);
            PG8_WAIT_V(8); PG8_WAIT_L(0); PG8_BAR; PG8_MMA(1, 0, At, B0); PG8_MMA(1, 1, At, B1); PG8_BAR; PG8_SCHED;
            PG8_LDB(B0, 1, 0); PG8_LDB(B1, 1, 1); PG8_SCHED; PG8_LDA(At, 1, 0); PG8_STAGE(PG8_SA(0, 1), a2 + hstep, voffA);
            PG8_WAIT_V(8); PG8_WAIT_L(0); PG8_BAR; PG8_MMA(0, 0, At, B0); PG8_MMA(0, 1, At, B1); PG8_BAR; PG8_SCHED;
            PG8_LDA(At, 1, 1); PG8_STAGE(PG8_SB(1, 0), b3, voffB); PG8_STAGE(PG8_SB(1, 1), b3 + hstep, voffB); PG8_STAGE(PG8_SA(1, 0), a3, voffA);
            PG8_WAIT_V(8); PG8_WAIT_L(0); PG8_BAR; PG8_MMA(1, 0, At, B0); PG8_MMA(1, 1, At, B1); PG8_BAR; PG8_SCHED;
            } else {
            PG8_LDB(B0, 0, 0); PG8_SCHED; PG8_LDA(At, 0, 0); PG8_STAGE(PG8_SA(1, 1), a1 + hstep, voffA);
            PG8_WAIT_L(8); PG8_BAR; PG8_WAIT_L(0); PG8_MMA(0, 0, At, B0); PG8_BAR; PG8_SCHED;
            PG8_LDB(B1, 0, 1); PG8_STAGE(PG8_SB(0, 0), b2, voffB);
            PG8_BAR; PG8_WAIT_L(0); PG8_MMA(0, 1, At, B1); PG8_BAR;
            PG8_LDA(At, 0, 1); PG8_STAGE(PG8_SA(0, 0), a2, voffA);
            PG8_BAR; PG8_WAIT_L(0); PG8_MMA(1, 0, At, B0); PG8_BAR; PG8_SCHED;
            PG8_STAGE(PG8_SB(0, 1), b2 + hstep, voffB);
            PG8_WAIT_V(6); PG8_BAR; PG8_MMA(1, 1, At, B1); PG8_BAR;
            PG8_LDB(B0, 1, 0); PG8_SCHED; PG8_LDA(At, 1, 0); PG8_STAGE(PG8_SA(0, 1), a2 + hstep, voffA);
            PG8_WAIT_L(8); PG8_BAR; PG8_WAIT_L(0); PG8_MMA(0, 0, At, B0); PG8_BAR; PG8_SCHED;
            PG8_LDB(B1, 1, 1); PG8_STAGE(PG8_SB(1, 0), b3, voffB);
            PG8_BAR; PG8_WAIT_L(0); PG8_MMA(0, 1, At, B1); PG8_BAR;
            PG8_LDA(At, 1, 1); PG8_STAGE(PG8_SA(1, 0), a3, voffA);
            PG8_BAR; PG8_WAIT_L(0); PG8_MMA(1, 0, At, B0); PG8_BAR; PG8_SCHED;
            PG8_STAGE(PG8_SB(1, 1), b3 + hstep, voffB);
            PG8_WAIT_V(6); PG8_BAR; PG8_MMA(1, 1, At, B1); PG8_BAR;
            }
        }
        if constexpr (ALIGN_EPI) { if (wr == 0) PG8_BAR; }
        if constexpr (!Epi::AFTER_DRAIN) { E(acc, cur, wr, wc, fr, fq); S.done(cur); }
        if (!has_next) break;
#pragma unroll
        for (int a = 0; a < 2; ++a)
#pragma unroll
            for (int b = 0; b < 2; ++b)
#pragma unroll
                for (int m = 0; m < 4; ++m)
#pragma unroll
                    for (int n = 0; n < 2; ++n) acc[a][b][m][n] = (f32x4){0.f, 0.f, 0.f, 0.f};
        cur = nxt; cA = nA; cB = nB; ++ui;
        if constexpr (ALIGN_EPI) { if (wr == 1) PG8_BAR; }
    }
    PG8_WAIT_V(0);
    if constexpr (!ALIGN_EPI) { if (wr == 0) PG8_BAR; }
    PG8_BAR;
    if constexpr (Epi::AFTER_DRAIN) { E.fused(acc, cur, wr, wc, fr, fq, lds, wid, lane); S.done(cur); }
#undef PG8_SA
#undef PG8_SB
#undef PG8_STAGE
#undef PG8_LDA
#undef PG8_LDB
#undef PG8_MMA
#undef PG8_WAIT_V
#undef PG8_WAIT_L
#undef PG8_BAR
#undef PG8_SCHED
}
}

#define LAS __attribute__((address_space(3)))
using pg8::bf16_t; using pg8::bf16x8; using pg8::f32x4; using pg8::u32x4; using pg8::Unit; using pg8::cvt_pk_bf16;
typedef unsigned u32x2 __attribute__((ext_vector_type(2)));
typedef short s16x4 __attribute__((ext_vector_type(4)));
constexpr int T = 32768, SEQ = 2048, DM = 1024, NH = 4, QL = 384, KVL = 256, PW = 512, INW = 1216, FF = 4096;
constexpr int N1 = 1280;
constexpr float EPS = 1e-6f;
constexpr float QSCALE = 0.07216878364870322f * 1.4426950408889634f;
constexpr int NTHR = 512, NWAVES = 8;
constexpr int LDS_BYTES = 147456;

constexpr size_t MiB = 1u << 20;
constexpr size_t WS_WIN = 0, WS_WQ = 3 * MiB, WS_WK = 4 * MiB, WS_WV = 4 * MiB + 512 * 1024, WS_WO = 5 * MiB, WS_WUP = 7 * MiB, WS_WDN = 15 * MiB;
constexpr size_t WS_ROPE = 23 * MiB, WS_RSTDX = 31 * MiB, WS_SSQKV = 31 * MiB + 256 * 1024, WS_SSQQ = 32 * MiB, WS_SSQH = 33 * MiB, WS_SSQO = 35 * MiB;
constexpr size_t WS_HB = 40 * MiB, WS_XB = 104 * MiB, WS_CQ = 168 * MiB, WS_CKV = 192 * MiB, WS_KPE = 208 * MiB, WS_U = 212 * MiB, WS_Q = 244 * MiB, WS_KN = 292 * MiB,
                 WS_VT = 324 * MiB, WS_MIX = 356 * MiB, WS_ACT = 104 * MiB, WS_H2 = 360 * MiB, WS_END = 488 * MiB;
constexpr size_t WS_CTL = 38 * MiB, CTL_BYTES = 16384;

__device__ __forceinline__ float bf2f(unsigned short h) { return __uint_as_float((unsigned)h << 16); }
__device__ __forceinline__ u32x4 pack8(const f32x4 a, const f32x4 b) { u32x4 w; w.x = cvt_pk_bf16(a[0], a[1]); w.y = cvt_pk_bf16(a[2], a[3]); w.z = cvt_pk_bf16(b[0], b[1]); w.w = cvt_pk_bf16(b[2], b[3]); return w; }
__device__ __forceinline__ u32x2 pack4(const f32x4 a) { u32x2 w; w.x = cvt_pk_bf16(a[0], a[1]); w.y = cvt_pk_bf16(a[2], a[3]); return w; }
__device__ __forceinline__ float wave_sum(float v) {
#pragma unroll
    for (int o = 1; o < 64; o <<= 1) v += __shfl_xor(v, o);
    return v;
}
__device__ __forceinline__ float quad_fq_sum(float s) { s += __shfl_xor(s, 16); s += __shfl_xor(s, 32); return s; }
__device__ __forceinline__ float dot4(const f32x4 a) { return (a[0] * a[0] + a[1] * a[1]) + (a[2] * a[2] + a[3] * a[3]); }

__device__ __forceinline__ int ropeperm(int y) { const int w = y >> 5, rem = y & 31, fq = rem >> 3, n = (rem >> 2) & 1, j = rem & 3; return 16 * w + 4 * fq + j + 32 * n; }
__device__ __forceinline__ int cm_win(int g) { if (g < 256) return 384 + g; if (g < 512) return g - 256; if (g < 640) return 256 + (g - 512); if (g < 704) return 640 + ropeperm(g - 640); if (g < 768) return -1; return 704 + (g - 768); }
__device__ __forceinline__ int cm_wq(int g) { if (g < 512) return (g >> 7) * 192 + (g & 127); const int x = g - 512; return (x >> 6) * 192 + 128 + ropeperm(x & 63); }
__device__ __forceinline__ int cm_wk(int g) { return (g >> 7) * 256 + (g & 127); }
__device__ __forceinline__ int cm_wv(int g) { return (g >> 7) * 256 + 128 + (g & 127); }

__device__ __forceinline__ void rope4(const f32x4 x1, const f32x4 x2, const float* cs, f32x4& lo, f32x4& hi) {
    const f32x4 t0 = *(const f32x4*)cs, t1 = *(const f32x4*)(cs + 4);
    const f32x4 c = {t0[0], t0[2], t1[0], t1[2]}, s = {t0[1], t0[3], t1[1], t1[3]};
    lo = x1 * c - x2 * s; hi = x2 * c + x1 * s;
}

struct Epi1 {
    static constexpr bool PERM = true, AFTER_DRAIN = false;
    const float* rstd_x; const float* rope; bf16_t* Ckv; bf16_t* Cq; bf16_t* Kpe; bf16_t* U; float* ssq_kv; float* ssq_q;
    __device__ __forceinline__ void operator()(const f32x4 (&acc)[2][2][4][2], const Unit& u, int wr, int wc, int fr, int fq) const {
        const int pn = u.pn, c8 = wc * 32 + 8 * fq;
#pragma unroll
        for (int ai = 0; ai < 2; ++ai)
#pragma unroll
            for (int m = 0; m < 4; ++m) {
                const int row = u.pm * 256 + ai * 128 + wr * 64 + m * 16 + fr;
                const float rs = rstd_x[row];
                f32x4 v[2][2];
#pragma unroll
                for (int bj = 0; bj < 2; ++bj)
#pragma unroll
                    for (int n = 0; n < 2; ++n) v[bj][n] = acc[ai][bj][m][n] * rs;
                if (pn == 0) {
                    *(u32x4*)(Ckv + (size_t)row * KVL + c8) = pack8(v[0][0], v[0][1]); *(u32x4*)(Ckv + (size_t)row * KVL + 128 + c8) = pack8(v[1][0], v[1][1]);
                    const float s = quad_fq_sum((dot4(v[0][0]) + dot4(v[0][1])) + (dot4(v[1][0]) + dot4(v[1][1])));
                    if (fq == 0) ssq_kv[row * 4 + wc] = s;
                } else if (pn == 1) {
                    *(u32x4*)(Cq + (size_t)row * QL + c8) = pack8(v[0][0], v[0][1]); *(u32x4*)(Cq + (size_t)row * QL + 128 + c8) = pack8(v[1][0], v[1][1]);
                    const float s = quad_fq_sum((dot4(v[0][0]) + dot4(v[0][1])) + (dot4(v[1][0]) + dot4(v[1][1])));
                    if (fq == 0) ssq_q[row * 8 + wc] = s;
                } else if (pn == 2) {
                    *(u32x4*)(Cq + (size_t)row * QL + 256 + c8) = pack8(v[0][0], v[0][1]);
                    const float s = quad_fq_sum(dot4(v[0][0]) + dot4(v[0][1]));
                    if (fq == 0) ssq_q[row * 8 + 4 + wc] = s;
                    if (wc < 2) { const int i0 = 16 * wc + 4 * fq; f32x4 lo, hi; rope4(v[1][0], v[1][1], rope + (size_t)row * 64 + 2 * i0, lo, hi);
                        *(u32x2*)(Kpe + (size_t)row * 64 + i0) = pack4(lo); *(u32x2*)(Kpe + (size_t)row * 64 + 32 + i0) = pack4(hi); }
                } else {
                    bf16_t* d = U + (size_t)row * PW + (pn - 3) * 256 + c8;
                    *(u32x4*)d = pack8(v[0][0], v[0][1]); *(u32x4*)(d + 128) = pack8(v[1][0], v[1][1]);
                }
                asm volatile("" ::: "memory");
            }
    }
};
struct Epi2 {
    static constexpr bool PERM = true, AFTER_DRAIN = false;
    const float* ssq_q; const float* rope; bf16_t* Q;
    __device__ __forceinline__ void operator()(const f32x4 (&acc)[2][2][4][2], const Unit& u, int wr, int wc, int fr, int fq) const {
        const int pn = u.pn, c8 = wc * 32 + 8 * fq;
#pragma unroll
        for (int ai = 0; ai < 2; ++ai)
#pragma unroll
            for (int m = 0; m < 4; ++m) {
                const int row = u.pm * 256 + ai * 128 + wr * 64 + m * 16 + fr;
                const f32x4 p0 = *(const f32x4*)(ssq_q + row * 8), p1 = *(const f32x4*)(ssq_q + row * 8 + 4);
                const float rs = rsqrtf(((p0[0] + p0[1]) + (p0[2] + p0[3]) + (p1[0] + p1[1]) + (p1[2] + p1[3])) * (1.0f / QL) + EPS) * QSCALE;
                bf16_t* qrow = Q + (size_t)row * 768;
#pragma unroll
                for (int bj = 0; bj < 2; ++bj) {
                    const f32x4 v0 = acc[ai][bj][m][0] * rs, v1 = acc[ai][bj][m][1] * rs;
                    if (pn < 2) { *(u32x4*)(qrow + (pn * 2 + bj) * 192 + c8) = pack8(v0, v1); }
                    else { const int head = 2 * bj + (wc >> 1), i0 = 16 * (wc & 1) + 4 * fq; f32x4 lo, hi; rope4(v0, v1, rope + (size_t)row * 64 + 2 * i0, lo, hi);
                        *(u32x2*)(qrow + head * 192 + 128 + i0) = pack4(lo); *(u32x2*)(qrow + head * 192 + 160 + i0) = pack4(hi); }
                }
                asm volatile("" ::: "memory");
            }
    }
};
struct Epi3a {
    static constexpr bool PERM = true, AFTER_DRAIN = false;
    const float* ssq_kv; bf16_t* Kn;
    __device__ __forceinline__ void operator()(const f32x4 (&acc)[2][2][4][2], const Unit& u, int wr, int wc, int fr, int fq) const {
        const int c8 = u.pn * 256 + wc * 32 + 8 * fq;
#pragma unroll
        for (int ai = 0; ai < 2; ++ai)
#pragma unroll
            for (int m = 0; m < 4; ++m) {
                const int row = u.pm * 256 + ai * 128 + wr * 64 + m * 16 + fr;
                const f32x4 p0 = *(const f32x4*)(ssq_kv + row * 4);
                const float rs = rsqrtf(((p0[0] + p0[1]) + (p0[2] + p0[3])) * (1.0f / KVL) + EPS);
#pragma unroll
                for (int bj = 0; bj < 2; ++bj) *(u32x4*)(Kn + (size_t)row * 512 + bj * 128 + c8) = pack8(acc[ai][bj][m][0] * rs, acc[ai][bj][m][1] * rs);
                asm volatile("" ::: "memory");
            }
    }
};
struct Epi3b {
    static constexpr bool PERM = true, AFTER_DRAIN = false;
    const float* ssq_kv; bf16_t* Vt;
    __device__ __forceinline__ void operator()(const f32x4 (&acc)[2][2][4][2], const Unit& u, int wr, int wc, int fr, int fq) const {
        const int t8 = u.pn * 256 + wc * 32 + 8 * fq;
#pragma unroll
        for (int bj = 0; bj < 2; ++bj) {
            f32x4 rs[2];
#pragma unroll
            for (int e = 0; e < 8; ++e) { const f32x4 p0 = *(const f32x4*)(ssq_kv + (size_t)(t8 + bj * 128 + e) * 4);
                rs[e >> 2][e & 3] = rsqrtf(((p0[0] + p0[1]) + (p0[2] + p0[3])) * (1.0f / KVL) + EPS); }
#pragma unroll
            for (int ai = 0; ai < 2; ++ai)
#pragma unroll
                for (int m = 0; m < 4; ++m) {
                    const int hv = u.pm * 256 + ai * 128 + wr * 64 + m * 16 + fr;
                    *(u32x4*)(Vt + (size_t)hv * T + bj * 128 + t8) = pack8(acc[ai][bj][m][0] * rs[0], acc[ai][bj][m][1] * rs[1]);
                }
            asm volatile("" ::: "memory");
        }
    }
};
struct Epi4 {
    static constexpr bool PERM = true, AFTER_DRAIN = false;
    const float* x; float* out; bf16_t* Hb; float* ssq_h;
    __device__ __forceinline__ void operator()(const f32x4 (&acc)[2][2][4][2], const Unit& u, int wr, int wc, int fr, int fq) const {
        const int c8 = u.pn * 256 + wc * 32 + 8 * fq;
#pragma unroll
        for (int ai = 0; ai < 2; ++ai)
#pragma unroll
            for (int m = 0; m < 4; ++m) {
                const int row = u.pm * 256 + ai * 128 + wr * 64 + m * 16 + fr;
                float s = 0.f;
#pragma unroll
                for (int bj = 0; bj < 2; ++bj) { const size_t off = (size_t)row * DM + bj * 128 + c8;
                    const f32x4 h0 = *(const f32x4*)(x + off) + acc[ai][bj][m][0], h1 = *(const f32x4*)(x + off + 4) + acc[ai][bj][m][1];
                    *(f32x4*)(out + off) = h0; *(f32x4*)(out + off + 4) = h1; *(u32x4*)(Hb + off) = pack8(h0, h1); s += dot4(h0) + dot4(h1); }
                s = quad_fq_sum(s);
                if (fq == 0) ssq_h[row * 16 + u.pn * 4 + wc] = s;
                asm volatile("" ::: "memory");
            }
    }
};
struct Epi5 {
    static constexpr bool PERM = true, AFTER_DRAIN = false;
    const float* ssq_h; bf16_t* Act;
    __device__ __forceinline__ void operator()(const f32x4 (&acc)[2][2][4][2], const Unit& u, int wr, int wc, int fr, int fq) const {
        const int c8 = u.pn * 256 + wc * 32 + 8 * fq;
#pragma unroll
        for (int ai = 0; ai < 2; ++ai)
#pragma unroll
            for (int m = 0; m < 4; ++m) {
                const int row = u.pm * 256 + ai * 128 + wr * 64 + m * 16 + fr;
                const f32x4 p0 = *(const f32x4*)(ssq_h + row * 16), p1 = *(const f32x4*)(ssq_h + row * 16 + 4), p2 = *(const f32x4*)(ssq_h + row * 16 + 8), p3 = *(const f32x4*)(ssq_h + row * 16 + 12);
                const f32x4 ps = (p0 + p1) + (p2 + p3);
                const float rs = rsqrtf(((ps[0] + ps[1]) + (ps[2] + ps[3])) * (1.0f / DM) + EPS);
#pragma unroll
                for (int bj = 0; bj < 2; ++bj) { f32x4 v0 = acc[ai][bj][m][0] * rs, v1 = acc[ai][bj][m][1] * rs;
#pragma unroll
                    for (int e = 0; e < 4; ++e) { const float a = fmaxf(v0[e], 0.f), b = fmaxf(v1[e], 0.f); v0[e] = a * a; v1[e] = b * b; }
                    *(u32x4*)(Act + (size_t)row * FF + bj * 128 + c8) = pack8(v0, v1); }
                asm volatile("" ::: "memory");
            }
    }
};
struct Epi6 {
    static constexpr bool PERM = true, AFTER_DRAIN = false;
    const float* hin; float* out; float* ssq_o;
    __device__ __forceinline__ void operator()(const f32x4 (&acc)[2][2][4][2], const Unit& u, int wr, int wc, int fr, int fq) const {
        const int c8 = u.pn * 256 + wc * 32 + 8 * fq;
#pragma unroll
        for (int ai = 0; ai < 2; ++ai)
#pragma unroll
            for (int m = 0; m < 4; ++m) {
                const int row = u.pm * 256 + ai * 128 + wr * 64 + m * 16 + fr;
                float s = 0.f;
#pragma unroll
                for (int bj = 0; bj < 2; ++bj) { const size_t off = (size_t)row * DM + bj * 128 + c8;
                    const f32x4 h0 = *(const f32x4*)(hin + off) + acc[ai][bj][m][0], h1 = *(const f32x4*)(hin + off + 4) + acc[ai][bj][m][1];
                    *(f32x4*)(out + off) = h0; *(f32x4*)(out + off + 4) = h1; s += dot4(h0) + dot4(h1); }
                s = quad_fq_sum(s);
                if (fq == 0) ssq_o[row * 16 + u.pn * 4 + wc] = s;
                asm volatile("" ::: "memory");
            }
    }
};

#define LDS_WAIT() asm volatile("s_waitcnt lgkmcnt(0)" ::: "memory")
template <int MAT>
__device__ __forceinline__ void tr_item(const float* __restrict__ W, int ldw, const float* __restrict__ gain, bf16_t* __restrict__ WT, int ldd, int nblk, LAS float* scr, int item, int lane) {
    const int kb = item / nblk, nb = item % nblk, k0 = 64 * kb, n0 = 32 * nb, gcol = n0 + (lane & 31);
    const int sc = MAT == 0 ? cm_win(gcol) : MAT == 1 ? cm_wq(gcol) : MAT == 2 ? cm_wk(gcol) : MAT == 3 ? cm_wv(gcol) : gcol;
#pragma unroll 8
    for (int i = 0; i < 32; ++i) { const int kk = 2 * i + (lane >> 5); float v = 0.f;
        if (sc >= 0) { v = W[(size_t)(k0 + kk) * ldw + sc]; if (gain) v *= gain[k0 + kk]; }
        scr[kk * 33 + (lane & 31)] = v; }
    LDS_WAIT(); asm volatile("" ::: "memory");
    const int c = lane & 7;
#pragma unroll
    for (int j = 0; j < 4; ++j) { const int n = (lane >> 3) + 8 * j; const LAS float* s = scr + (8 * c) * 33 + n;
        u32x4 o; o.x = cvt_pk_bf16(s[0 * 33], s[1 * 33]); o.y = cvt_pk_bf16(s[2 * 33], s[3 * 33]); o.z = cvt_pk_bf16(s[4 * 33], s[5 * 33]); o.w = cvt_pk_bf16(s[6 * 33], s[7 * 33]);
        *(u32x4*)(WT + (size_t)(n0 + n) * ldd + k0 + 8 * c) = o; }
    LDS_WAIT(); asm volatile("" ::: "memory");
}

template <int W>
__device__ __forceinline__ void pool_item(const bf16_t* __restrict__ U, bf16_t* __restrict__ Mix, int chunk, int gg, int lane) {
    const int sub = lane >> 4, c = lane & 15, r0 = chunk * 32 + sub * 8, s0 = r0 & (SEQ - 1);
    const bf16_t* up = U + (size_t)r0 * PW + gg * 128 + c * 8;
    u32x4 raw[W + 7];
#pragma unroll
    for (int j = 0; j < W + 7; ++j) { const int dj = j - (W - 1); raw[j] = (s0 + dj >= 0) ? *(const u32x4*)(up + (long)dj * PW) : (u32x4){0u, 0u, 0u, 0u}; }
    float S[8];
#pragma unroll
    for (int e = 0; e < 8; ++e) S[e] = 0.f;
#pragma unroll
    for (int j = 0; j < W; ++j)
#pragma unroll
        for (int e = 0; e < 4; ++e) { S[2 * e] += __uint_as_float(raw[j][e] << 16); S[2 * e + 1] += __uint_as_float(raw[j][e] & 0xffff0000u); }
    bf16_t* op = Mix + (size_t)r0 * DM + 512 + gg * 128 + c * 8;
#pragma unroll
    for (int i = 0; i < 8; ++i) {
        const int cnt = (s0 + i + 1 < W) ? s0 + i + 1 : W; const float ic = 1.0f / (float)cnt;
        const u32x4 cur = raw[i + W - 1]; u32x4 o;
#pragma unroll
        for (int e = 0; e < 4; ++e) o[e] = cvt_pk_bf16(S[2 * e] * ic - __uint_as_float(cur[e] << 16), S[2 * e + 1] * ic - __uint_as_float(cur[e] & 0xffff0000u));
        *(u32x4*)(op + (size_t)i * DM) = o;
        if (i < 7) {
#pragma unroll
            for (int e = 0; e < 4; ++e) { S[2 * e] += __uint_as_float(raw[i + W][e] << 16) - __uint_as_float(raw[i][e] << 16); S[2 * e + 1] += __uint_as_float(raw[i + W][e] & 0xffff0000u) - __uint_as_float(raw[i][e] & 0xffff0000u); }
        }
    }
}

constexpr int KN_B = 64 * 256, KR_B = 64 * 128, VT_B = 128 * 128, STG_B = KN_B + KR_B + VT_B;
static_assert(2 * STG_B <= 131072, "attention LDS");

__device__ __forceinline__ void attn_unit(LAS unsigned char* lds, const bf16_t* __restrict__ Q, const bf16_t* __restrict__ Kn, const bf16_t* __restrict__ Kpe,
                                          const bf16_t* __restrict__ Vt, bf16_t* __restrict__ Mix, int b, int h, int qb, int tid, int wid, int lane_in) {
    int lane = lane_in; asm volatile("" : "+v"(lane));
    const int fr = lane & 15, g = lane >> 4;
    const int q0 = qb * 256 + wid * 32;
    const size_t rb = (size_t)b * SEQ;
    bf16x8 qf[2][6];
#pragma unroll
    for (int q2 = 0; q2 < 2; ++q2)
#pragma unroll
        for (int ks = 0; ks < 6; ++ks) qf[q2][ks] = *(const bf16x8*)(Q + (rb + q0 + 16 * q2 + fr) * 768 + h * 192 + 32 * ks + 8 * g);
    f32x4 o[8][2];
#pragma unroll
    for (int vb = 0; vb < 8; ++vb) { o[vb][0] = (f32x4){0.f, 0.f, 0.f, 0.f}; o[vb][1] = (f32x4){0.f, 0.f, 0.f, 0.f}; }
    float mrun[2] = {-INFINITY, -INFINITY}, lrun[2] = {0.f, 0.f};
    const int nt = 4 * (qb + 1);
    unsigned oN[2], oV[2], oR;
#pragma unroll
    for (int r = 0; r < 2; ++r) { const int L = (r * 8 + wid) * 64 + lane;
        { const int key = L >> 4, pc = L & 15, cc = pc ^ (key & 15); oN[r] = (unsigned)(key * 1024 + cc * 16); }
        { const int vd = L >> 3, pc = L & 7, cc = pc ^ ((vd >> 1) & 7); oV[r] = (unsigned)(vd * (T * 2) + cc * 16); } }
    { const int L = wid * 64 + lane, key = L >> 3, pc = L & 7, cc = pc ^ ((key >> 1) & 7); oR = (unsigned)(key * 128 + cc * 16); }
    const char* bN = (const char*)(Kn + rb * 512 + h * 128); const char* bR = (const char*)(Kpe + rb * 64); const char* bV = (const char*)(Vt + (size_t)(h * 128) * T + rb);
#define ATT_DMA(kt, buf) do { LAS unsigned char* _d = lds + (buf) * STG_B; const char* _n = bN + (size_t)(kt) * (64 * 512 * 2); const char* _r = bR + (size_t)(kt) * (64 * 64 * 2); const char* _v = bV + (size_t)(kt) * 128; \
        __builtin_amdgcn_global_load_lds((const unsigned*)(_n + oN[0]), (LAS unsigned*)(_d + wid * 1024), 16, 0, 0); \
        __builtin_amdgcn_global_load_lds((const unsigned*)(_n + oN[1]), (LAS unsigned*)(_d + 8192 + wid * 1024), 16, 0, 0); \
        __builtin_amdgcn_global_load_lds((const unsigned*)(_r + oR), (LAS unsigned*)(_d + KN_B + wid * 1024), 16, 0, 0); \
        __builtin_amdgcn_global_load_lds((const unsigned*)(_v + oV[0]), (LAS unsigned*)(_d + KN_B + KR_B + wid * 1024), 16, 0, 0); \
        __builtin_amdgcn_global_load_lds((const unsigned*)(_v + oV[1]), (LAS unsigned*)(_d + KN_B + KR_B + 8192 + wid * 1024), 16, 0, 0); } while (0)
    const int swr = (fr >> 1) & 7;
    const int aN = fr * 256 + ((g ^ fr) << 4);
    const int aR = KN_B + fr * 128 + ((g ^ swr) << 4);
    const int aV = KN_B + KR_B + fr * 128 + (((g >> 1) ^ swr) << 4) + (g & 1) * 8;
    ATT_DMA(0, 0);
    asm volatile("s_waitcnt vmcnt(0)" ::: "memory");
    __syncthreads();
    for (int kt = 0; kt < nt; ++kt) {
        const int buf = kt & 1;
        if (kt + 1 < nt) ATT_DMA(kt + 1, buf ^ 1);
        if (kt * 64 <= q0 + 31) {
            LAS unsigned char* Sb = lds + buf * STG_B;
            f32x4 s[4][2];
#pragma unroll
            for (int kb = 0; kb < 4; ++kb) { s[kb][0] = (f32x4){0.f, 0.f, 0.f, 0.f}; s[kb][1] = (f32x4){0.f, 0.f, 0.f, 0.f}; }
#pragma unroll
            for (int ks = 0; ks < 6; ++ks) {
                bf16x8 kf[4];
#pragma unroll
                for (int kb = 0; kb < 4; ++kb) kf[kb] = (ks < 4) ? *(const LAS bf16x8*)(Sb + (aN ^ (ks * 64)) + kb * 4096) : *(const LAS bf16x8*)(Sb + (aR ^ ((ks - 4) * 64)) + kb * 2048);
#pragma unroll
                for (int kb = 0; kb < 4; ++kb) {
                    s[kb][0] = __builtin_amdgcn_mfma_f32_16x16x32_bf16(kf[kb], qf[0][ks], s[kb][0], 0, 0, 0);
                    s[kb][1] = __builtin_amdgcn_mfma_f32_16x16x32_bf16(kf[kb], qf[1][ks], s[kb][1], 0, 0, 0); }
            }
            if (kt * 64 + 63 > q0) {
#pragma unroll
                for (int q2 = 0; q2 < 2; ++q2) { const int qi = q0 + 16 * q2 + fr;
#pragma unroll
                    for (int kb = 0; kb < 4; ++kb)
#pragma unroll
                        for (int i = 0; i < 4; ++i) if (kt * 64 + 16 * kb + 4 * g + i > qi) s[kb][q2][i] = -INFINITY; }
            }
            bf16x8 pb[2][2];
#pragma unroll
            for (int q2 = 0; q2 < 2; ++q2) {
                float mx = fmaxf(fmaxf(s[0][q2][0], s[0][q2][1]), fmaxf(s[0][q2][2], s[0][q2][3]));
#pragma unroll
                for (int kb = 1; kb < 4; ++kb) mx = fmaxf(mx, fmaxf(fmaxf(s[kb][q2][0], s[kb][q2][1]), fmaxf(s[kb][q2][2], s[kb][q2][3])));
                mx = fmaxf(mx, __shfl_xor(mx, 16)); mx = fmaxf(mx, __shfl_xor(mx, 32));
                const float mnew = fmaxf(mrun[q2], mx), alpha = __builtin_amdgcn_exp2f(mrun[q2] - mnew);
                mrun[q2] = mnew;
                float rsum = 0.f;
#pragma unroll
                for (int kb = 0; kb < 4; ++kb)
#pragma unroll
                    for (int i = 0; i < 4; ++i) { const float p = __builtin_amdgcn_exp2f(s[kb][q2][i] - mnew); s[kb][q2][i] = p; rsum += p; }
                lrun[q2] = lrun[q2] * alpha + rsum;
#pragma unroll
                for (int vb = 0; vb < 8; ++vb) o[vb][q2] = o[vb][q2] * alpha;
#pragma unroll
                for (int k2 = 0; k2 < 2; ++k2) { const u32x4 w = pack8(s[2 * k2][q2], s[2 * k2 + 1][q2]); pb[q2][k2] = __builtin_bit_cast(bf16x8, w); }
            }
#pragma unroll
            for (int k2 = 0; k2 < 2; ++k2)
#pragma unroll
                for (int vq = 0; vq < 2; ++vq) {
                    bf16x8 vf[4];
#pragma unroll
                    for (int v4 = 0; v4 < 4; ++v4) { const LAS unsigned char* vp = Sb + (aV ^ (k2 * 64)) + (4 * vq + v4) * 2048; const LAS unsigned char* vph = Sb + (aV ^ (k2 * 64) ^ 32) + (4 * vq + v4) * 2048;
                        const s16x4 lo = *(const LAS s16x4*)vp, hi = *(const LAS s16x4*)vph;
                        vf[v4] = (bf16x8){lo[0], lo[1], lo[2], lo[3], hi[0], hi[1], hi[2], hi[3]}; }
#pragma unroll
                    for (int v4 = 0; v4 < 4; ++v4) {
                        o[4 * vq + v4][0] = __builtin_amdgcn_mfma_f32_16x16x32_bf16(vf[v4], pb[0][k2], o[4 * vq + v4][0], 0, 0, 0);
                        o[4 * vq + v4][1] = __builtin_amdgcn_mfma_f32_16x16x32_bf16(vf[v4], pb[1][k2], o[4 * vq + v4][1], 0, 0, 0); }
                }
        }
        asm volatile("s_waitcnt vmcnt(0)" ::: "memory");
        __syncthreads();
    }
#undef ATT_DMA
#pragma unroll
    for (int q2 = 0; q2 < 2; ++q2) {
        const float l = quad_fq_sum(lrun[q2]), inv = 1.0f / l;
        bf16_t* orow = Mix + (rb + q0 + 16 * q2 + fr) * DM + h * 128 + 4 * g;
#pragma unroll
        for (int vb = 0; vb < 8; ++vb) *(u32x2*)(orow + 16 * vb) = pack4(o[vb][q2] * inv);
    }
}

#define XB_TMO      128
#define XB_XCNT(j)  (256  + 64 * (j))
#define XB_XSUB(j)  (1280 + 64 * (j))
#define XB_XGEN(j)  (2304 + 64 * (j))
#define XB_TOP      3328
#define XB_TOPGEN   3392
#define XCD_BAR_WORDS 3456
#define XB_SPIN_CAP (1u << 18)

__device__ __forceinline__ unsigned xb_ld(unsigned* p)              { return __hip_atomic_load(p, __ATOMIC_RELAXED, __HIP_MEMORY_SCOPE_AGENT); }
__device__ __forceinline__ unsigned xb_add(unsigned* p, unsigned v) { return __hip_atomic_fetch_add(p, v, __ATOMIC_RELAXED, __HIP_MEMORY_SCOPE_AGENT); }
__device__ __forceinline__ unsigned xb_xcc_id() { return (unsigned)__builtin_amdgcn_s_getreg((3 << 11) | 20) & 0xFu; }
#define XB_SPIN(cond, bar) do { unsigned _sp = 0; while (cond) { __builtin_amdgcn_s_sleep(1); \
    if ((++_sp & 255u) == 0u) { if (xb_ld(&(bar)[XB_TMO])) break; if (_sp > XB_SPIN_CAP) { atomicAdd(&(bar)[XB_TMO], 1u); break; } } } } while (0)

struct XcdBarrier {
    unsigned* bar; unsigned x;
    volatile LAS unsigned* st;
};

__device__ __forceinline__ XcdBarrier xcd_barrier_post(unsigned* bar, volatile LAS unsigned* st) {
    XcdBarrier b; b.bar = bar; b.x = xb_xcc_id(); b.st = st;
    if (threadIdx.x == 0) (void)xb_add(&bar[XB_XCNT(b.x)], 1u);
    return b;
}
__device__ __forceinline__ void xcd_barrier_complete(unsigned* bar, unsigned x, unsigned& nloc, unsigned& nx) {
    const unsigned G = gridDim.x * gridDim.y * gridDim.z;
    unsigned sum, cnt, mine, sp = 0u;
    for (;;) {
        sum = 0u; cnt = 0u; mine = 0u;
#pragma unroll
        for (unsigned j = 0; j < 16; ++j) { const unsigned c = xb_ld(&bar[XB_XCNT(j)]); sum += c; cnt += (c > 0u) ? 1u : 0u; mine = (j == x) ? c : mine; }
        if (sum == G) break;
        __builtin_amdgcn_s_sleep(1);
        if ((++sp & 255u) == 0u) { if (xb_ld(&bar[XB_TMO])) break; if (sp > XB_SPIN_CAP) { atomicAdd(&bar[XB_TMO], 1u); break; } }
    }
    nloc = mine > 0u ? mine : 1u; nx = cnt > 0u ? cnt : 1u;
}

__device__ __forceinline__ void xcd_barrier(const XcdBarrier& b) {
    asm volatile("s_waitcnt vmcnt(0)" ::: "memory");
    __syncthreads();
    if (threadIdx.x == 0) {
        unsigned* bar = b.bar;
        __builtin_amdgcn_s_waitcnt(0);
        unsigned nloc = b.st[0], nx = b.st[1];
        if (nloc == 0u) { xcd_barrier_complete(bar, b.x, nloc, nx); b.st[0] = nloc; b.st[1] = nx; }
        const unsigned old = xb_add(&bar[XB_XSUB(b.x)], 1u);
        const unsigned gen = old / nloc;
        if (old + 1u == (gen + 1u) * nloc) {
            __builtin_amdgcn_fence(__ATOMIC_RELEASE, "agent");
            asm volatile("s_waitcnt vmcnt(0)" ::: "memory");
            const unsigned og = xb_add(&bar[XB_TOP], 1u);
            const unsigned tg = og / nx;
            if (og + 1u == (tg + 1u) * nx) xb_add(&bar[XB_TOPGEN], 1u);
            else XB_SPIN(xb_ld(&bar[XB_TOPGEN]) == tg, bar);
            __builtin_amdgcn_fence(__ATOMIC_ACQUIRE, "agent");
            xb_add(&bar[XB_XGEN(b.x)], 1u);
            asm volatile("s_waitcnt vmcnt(0)" ::: "memory");
        } else {
            XB_SPIN(xb_ld(&bar[XB_XGEN(b.x)]) == gen, bar);
            __builtin_amdgcn_fence(__ATOMIC_ACQUIRE, "agent");
            asm volatile("s_waitcnt vmcnt(0)" ::: "memory");
        }
    }
    __syncthreads();
}

#ifndef REPMASK
#define REPMASK 0
#endif
struct Args { const float* in[15]; float* out; unsigned char* ws; };
__global__ void __launch_bounds__(NTHR, 2) mk_fwd(Args a) {
    extern __shared__ __attribute__((aligned(16))) unsigned char lds_raw[];
    LAS unsigned char* lds = (LAS unsigned char*)lds_raw;
    cg::grid_group grid = cg::this_grid();
    const int tid = threadIdx.x, lane = tid & 63, wid = __builtin_amdgcn_readfirstlane(tid >> 6);
    const int G = gridDim.x, bx = blockIdx.x, vcu = (G % 8 == 0) ? (bx % 8) * (G / 8) + bx / 8 : bx;
    const int gw = vcu * NWAVES + wid, NGW = G * NWAVES, gtid = bx * NTHR + tid, NT = G * NTHR;
    unsigned char* ws = a.ws;
    volatile LAS unsigned* MISC = (volatile LAS unsigned*)(lds + 131072);
    if (tid < 64) MISC[tid] = 0u;
    __syncthreads();
    XcdBarrier xbar = xcd_barrier_post((unsigned*)(ws + WS_CTL), MISC + 8);
    const float* x = a.in[0]; const int* pos = (const int*)a.in[1]; const float* g_mix = a.in[2]; const float* w_in = a.in[3]; const float* g_q = a.in[4]; const float* w_q = a.in[5];
    const float* g_kv = a.in[6]; const float* w_kv = a.in[7]; const float* pool_w = a.in[8]; const float* pool_s = a.in[9]; const float* w_out = a.in[10]; const float* g_mlp = a.in[11];
    const float* w_up = a.in[12]; const float* w_dn = a.in[13]; const float* g_fin = a.in[14]; float* out = a.out;
    bf16_t* Win_t = (bf16_t*)(ws + WS_WIN); bf16_t* Wq_t = (bf16_t*)(ws + WS_WQ); bf16_t* Wk_t = (bf16_t*)(ws + WS_WK); bf16_t* Wv_t = (bf16_t*)(ws + WS_WV); bf16_t* Wo_t = (bf16_t*)(ws + WS_WO);
    bf16_t* Wup_t = (bf16_t*)(ws + WS_WUP); bf16_t* Wdn_t = (bf16_t*)(ws + WS_WDN);
    float* rope = (float*)(ws + WS_ROPE); float* rstd_x = (float*)(ws + WS_RSTDX); float* ssq_kv = (float*)(ws + WS_SSQKV); float* ssq_q = (float*)(ws + WS_SSQQ);
    float* ssq_h = (float*)(ws + WS_SSQH); float* ssq_o = (float*)(ws + WS_SSQO);
    bf16_t* Hb = (bf16_t*)(ws + WS_HB); bf16_t* Xb = (bf16_t*)(ws + WS_XB); bf16_t* Cq = (bf16_t*)(ws + WS_CQ); bf16_t* Ckv = (bf16_t*)(ws + WS_CKV); bf16_t* Kpe = (bf16_t*)(ws + WS_KPE);
    bf16_t* U = (bf16_t*)(ws + WS_U); bf16_t* Qb = (bf16_t*)(ws + WS_Q); bf16_t* Kn = (bf16_t*)(ws + WS_KN); bf16_t* Vt = (bf16_t*)(ws + WS_VT); bf16_t* Mix = (bf16_t*)(ws + WS_MIX);
    bf16_t* Act = (bf16_t*)(ws + WS_ACT); float* H2 = (float*)(ws + WS_H2);

    for (int rep_ = 0; rep_ <= ((REPMASK >> 0) & 1); ++rep_) {
    {
        LAS float* scr = (LAS float*)(lds + wid * 16384);
        constexpr int I_IN = 16 * (N1 / 32), I_Q = 6 * 24, I_K = 4 * 16, I_V = 4 * 16, I_O = 8 * 32, I_UP = 16 * 128, I_DN = 64 * 32;
        constexpr int NITEMS = I_IN + I_Q + I_K + I_V + I_O + I_UP + I_DN;
        for (int it = gw; it < NITEMS; it += NGW) {
            int r = it;
            if (r < I_UP) { tr_item<4>(w_up, FF, g_mlp, Wup_t, DM, FF / 32, scr, r, lane); continue; } r -= I_UP;
            if (r < I_DN) { tr_item<4>(w_dn, DM, nullptr, Wdn_t, FF, DM / 32, scr, r, lane); continue; } r -= I_DN;
            if (r < I_IN) { tr_item<0>(w_in, INW, g_mix, Win_t, DM, N1 / 32, scr, r, lane); continue; } r -= I_IN;
            if (r < I_Q) { tr_item<1>(w_q, 768, g_q, Wq_t, QL, 24, scr, r, lane); continue; } r -= I_Q;
            if (r < I_K) { tr_item<2>(w_kv, 1024, g_kv, Wk_t, KVL, 16, scr, r, lane); continue; } r -= I_K;
            if (r < I_V) { tr_item<3>(w_kv, 1024, g_kv, Wv_t, KVL, 16, scr, r, lane); continue; } r -= I_V;
            tr_item<4>(w_out, DM, nullptr, Wo_t, DM, 32, scr, r, lane);
        }
        for (int wi = gw; wi < 1024; wi += NGW) {
            const int nb = wi & 15, c8 = (wi >> 4) & 15, gg = wi >> 8, n = nb * 64 + lane;
            float accv[8];
#pragma unroll
            for (int cc = 0; cc < 8; ++cc) accv[cc] = 0.f;
            const float* pw = pool_w + (size_t)(gg * 128 + c8 * 8) * 128; const float* ps = pool_s + gg * 128; const float* wo = w_out + (size_t)(512 + gg * 128) * DM + n;
#pragma unroll 16
            for (int d = 0; d < 128; ++d) { const float wv = wo[(size_t)d * DM] * ps[d];
#pragma unroll
                for (int cc = 0; cc < 8; ++cc) accv[cc] += pw[cc * 128 + d] * wv; }
            u32x4 o; o.x = cvt_pk_bf16(accv[0], accv[1]); o.y = cvt_pk_bf16(accv[2], accv[3]); o.z = cvt_pk_bf16(accv[4], accv[5]); o.w = cvt_pk_bf16(accv[6], accv[7]);
            *(u32x4*)(Wo_t + (size_t)n * DM + 512 + gg * 128 + c8 * 8) = o;
        }
        for (int it = gtid; it < T * 32; it += NT) {
            const int row = it >> 5, i = it & 31;
            const float inv = exp2f(-(float)i * (13.287712379549449f / 32.0f));
            const float ang = (float)pos[row] * inv;
            double rev = (double)ang * 0.15915494309189535; rev -= rint(rev);
            const float fr_ = (float)rev;
            rope[2 * it] = __builtin_amdgcn_cosf(fr_); rope[2 * it + 1] = __builtin_amdgcn_sinf(fr_);
        }
        for (int row = gw; row < T; row += NGW) {
            const f32x4* xr = (const f32x4*)(x + (size_t)row * DM) + lane;
            f32x4 v[4]; float s = 0.f;
#pragma unroll
            for (int j = 0; j < 4; ++j) { v[j] = xr[64 * j]; s += dot4(v[j]); }
            s = wave_sum(s);
            if (lane == 0) rstd_x[row] = rsqrtf(s * (1.0f / DM) + EPS);
            u32x2* o8 = (u32x2*)(Xb + (size_t)row * DM) + lane;
#pragma unroll
            for (int j = 0; j < 4; ++j) o8[64 * j] = pack4(v[j]);
        }
    }
    }
    grid.sync();
    for (int rep_ = 0; rep_ <= ((REPMASK >> 1) & 1); ++rep_) {
    {
        pg8::Gemm g{Xb, Win_t, T, N1, DM}; pg8::StaticOrder S; S.init(T, N1, G, bx);
        Epi1 E{rstd_x, rope, Ckv, Cq, Kpe, U, ssq_kv, ssq_q};
        pg8::gemm_phase<Epi1, pg8::StaticOrder, true, true>(lds, g, S, E);
    }
    }
    xcd_barrier(xbar);
    for (int rep_ = 0; rep_ <= ((REPMASK >> 2) & 1); ++rep_) {
    {
        for (int wi = gw; wi < 4 * (T / 32); wi += NGW) {
            const int gg = wi & 3, chunk = wi >> 2;
            if (gg == 0) pool_item<2>(U, Mix, chunk, 0, lane); else if (gg == 1) pool_item<4>(U, Mix, chunk, 1, lane);
            else if (gg == 2) pool_item<8>(U, Mix, chunk, 2, lane); else pool_item<16>(U, Mix, chunk, 3, lane);
        }
        { pg8::Gemm g{Cq, Wq_t, T, 768, QL}; pg8::StaticOrder S; S.init(T, 768, G, bx); Epi2 E{ssq_q, rope, Qb};
          pg8::gemm_phase<Epi2, pg8::StaticOrder, true, true>(lds, g, S, E); }
        { pg8::Gemm g{Ckv, Wk_t, T, 512, KVL}; pg8::StaticOrder S; S.init(T, 512, G, bx); Epi3a E{ssq_kv, Kn};
          pg8::gemm_phase<Epi3a, pg8::StaticOrder, true, true>(lds, g, S, E); }
        { pg8::Gemm g{Wv_t, Ckv, 512, T, KVL}; pg8::StaticOrder S; S.init(512, T, G, bx); Epi3b E{ssq_kv, Vt};
          pg8::gemm_phase<Epi3b, pg8::StaticOrder, true, true>(lds, g, S, E); }
    }
    }
    xcd_barrier(xbar);
    for (int rep_ = 0; rep_ <= ((REPMASK >> 3) & 1); ++rep_) {
    for (int p = vcu; p < 256; p += G) {
        const int bh = p >> 2, pi = p & 3, b = bh >> 2, h = bh & 3;
        attn_unit(lds, Qb, Kn, Kpe, Vt, Mix, b, h, 7 - pi, tid, wid, lane);
        attn_unit(lds, Qb, Kn, Kpe, Vt, Mix, b, h, pi, tid, wid, lane);
    }
    }
    xcd_barrier(xbar);
    for (int rep_ = 0; rep_ <= ((REPMASK >> 4) & 1); ++rep_) {
    {
        pg8::Gemm g{Mix, Wo_t, T, DM, DM}; pg8::StaticOrder S; S.init(T, DM, G, bx); Epi4 E{x, out, Hb, ssq_h};
        pg8::gemm_phase<Epi4, pg8::StaticOrder, true, true>(lds, g, S, E);
    }
    }
    xcd_barrier(xbar);
    for (int rep_ = 0; rep_ <= ((REPMASK >> 5) & 1); ++rep_) {
    {
        pg8::Gemm g{Hb, Wup_t, T, FF, DM}; pg8::StaticOrder S; S.init(T, FF, G, bx); Epi5 E{ssq_h, Act};
        pg8::gemm_phase<Epi5, pg8::StaticOrder, true, true>(lds, g, S, E);
    }
    }
    xcd_barrier(xbar);
    for (int rep_ = 0; rep_ <= ((REPMASK >> 6) & 1); ++rep_) {
    {
        pg8::Gemm g{Act, Wdn_t, T, DM, FF}; pg8::StaticOrder S; S.init(T, DM, G, bx); Epi6 E{out, H2, ssq_o};
        pg8::gemm_phase<Epi6, pg8::StaticOrder, true, true>(lds, g, S, E);
    }
    }
    xcd_barrier(xbar);
    for (int rep_ = 0; rep_ <= ((REPMASK >> 7) & 1); ++rep_) {
#ifdef XSYNC
    for (int xs_ = 0; xs_ < XSYNC; ++xs_) xcd_barrier(xbar);
#endif
    for (int row = gw; row < T; row += NGW) {
        float s = ssq_o[row * 16 + (lane & 15)];
        s += __shfl_xor(s, 1); s += __shfl_xor(s, 2); s += __shfl_xor(s, 4); s += __shfl_xor(s, 8);
        const float rs = rsqrtf(s * (1.0f / DM) + EPS);
        f32x4* orow = (f32x4*)(out + (size_t)row * DM) + lane; const f32x4* hrow = (const f32x4*)(H2 + (size_t)row * DM) + lane; const f32x4* gr = (const f32x4*)g_fin + lane;
#pragma unroll
        for (int j = 0; j < 4; ++j) orow[64 * j] = hrow[64 * j] * rs * gr[64 * j];
    }
    }
}

extern "C" void kernel_launch(void* const* d_in, const int* in_sizes, int n_in, void* d_out, int out_size, void* d_ws, size_t ws_size, hipStream_t stream) {
    static int grid = 0;
    if (grid == 0) {
        if (n_in != 15 || in_sizes[0] != T * DM || out_size != T * DM || ws_size < WS_END) { fprintf(stderr, "kernel_launch: unexpected shapes (n_in %d, in0 %d, out %d, ws %zu); nothing launched\n", n_in, n_in > 0 ? in_sizes[0] : -1, out_size, ws_size); grid = -1; return; }
        int dev = 0, cus = 0, per_cu = 0;
        if (hipGetDevice(&dev) != hipSuccess || hipDeviceGetAttribute(&cus, hipDeviceAttributeMultiprocessorCount, dev) != hipSuccess) { grid = -1; return; }
        if (hipFuncSetAttribute((const void*)mk_fwd, hipFuncAttributeMaxDynamicSharedMemorySize, LDS_BYTES) != hipSuccess) { fprintf(stderr, "kernel_launch: hipFuncSetAttribute failed\n"); grid = -1; return; }
        if (hipOccupancyMaxActiveBlocksPerMultiprocessor(&per_cu, (const void*)mk_fwd, NTHR, LDS_BYTES) != hipSuccess || per_cu < 1) per_cu = 1;
        (void)hipGetLastError();
        grid = cus * per_cu;
    }
    if (grid < 0) return;
    if (hipMemsetAsync((char*)d_ws + WS_CTL, 0, CTL_BYTES, stream) != hipSuccess) { fprintf(stderr, "kernel_launch: memset of the barrier words failed\n"); return; }
    Args a{};
    for (int i = 0; i < 15; ++i) a.in[i] = (const float*)d_in[i];
    a.out = (float*)d_out; a.ws = (unsigned char*)d_ws;
    void* args[] = {&a};
    const hipError_t e = hipLaunchCooperativeKernel((const void*)mk_fwd, dim3(grid), dim3(NTHR), args, LDS_BYTES, stream);
    if (e != hipSuccess) fprintf(stderr, "kernel_launch: cooperative launch failed: %s (grid %d)\n", hipGetErrorString(e), grid);
}
```

```cpp
#include <hip/hip_runtime.h>
#include <hip/hip_cooperative_groups.h>
#include <cstdio>
#include <cstdint>
namespace cg = cooperative_groups;
namespace pg8 {
#define PG8_LAS __attribute__((address_space(3)))
typedef unsigned short bf16_t;
typedef short bf16x8 __attribute__((ext_vector_type(8)));
typedef float f32x4 __attribute__((ext_vector_type(4)));
typedef unsigned u32x4 __attribute__((ext_vector_type(4)));
constexpr int BM = 256, BK = 64, HALF = 128, HTB = HALF * BK * 2  , STAGE_BYTES = 8 * HTB, NXCD = 8, WGM = 8;

__host__ __device__ __forceinline__ int lds_byte(int r, int c) { const int st = (r >> 4) * 2 + (c >> 5), rr = r & 15, cc = c & 31, ob = rr * 64 + cc * 2; return st * 1024 + (ob ^ (((ob >> 9) & 1) << 5)); }
__host__ __device__ __forceinline__ void stage_rc(int b, int& R, int& C) { const int st = b / 1024, sb = b % 1024, swz = sb ^ (((sb >> 9) & 1) << 5); R = (st >> 1) * 16 + swz / 64; C = (st & 1) * 32 + (swz % 64) / 2; }
__host__ __device__ __forceinline__ int perm32(int rho) { const int n = rho >> 4, i = rho & 15; return 8 * (i >> 2) + 4 * n + (i & 3); }

struct Unit { int pm, pn; };
struct Gemm { const bf16_t* A; const bf16_t* Bt; int M, N, K; };

struct StaticOrder {
    int nM, nN, nwg, G, c;
    __host__ __device__ void init(int M, int N, int G_, int c_) { nM = M / BM; nN = N / BM; nwg = nM * nN; G = G_; c = c_; }
    __host__ __device__ bool next(int i, Unit& u) const {
        const long L = (long)i * G + c; if (L >= nwg) return false;
        int wgid = (int)L; { const int q = nwg / NXCD, r = nwg % NXCD, xcd = wgid % NXCD, off = wgid / NXCD; wgid = (xcd < r ? xcd * (q + 1) : r * (q + 1) + (xcd - r) * q) + off; }
        const int nig = WGM * nN, gid = wgid / nig, fm = gid * WGM, gsz = (nM - fm) < WGM ? (nM - fm) : WGM;
        u.pm = fm + ((wgid % nig) % gsz); u.pn = (wgid % nig) / gsz; return true;
    }
    __device__ __forceinline__ void a_ready(const Unit&) const {}
    __device__ __forceinline__ void done(const Unit&) const {}
};

__device__ __forceinline__ unsigned cvt_pk_bf16(float lo, float hi) { unsigned r; asm volatile("v_cvt_pk_bf16_f32 %0, %1, %2" : "=v"(r) : "v"(lo), "v"(hi)); return r; }
typedef float f32x2 __attribute__((ext_vector_type(2)));
template <class Epi, class Sched, bool ALIGN_EPI = false, bool SP2 = false>
__device__ __forceinline__ void gemm_phase(PG8_LAS unsigned char* lds, const Gemm g, const Sched& S, const Epi& E) {
    int tid_l = threadIdx.x; asm volatile("" : "+v"(tid_l));
    const int tid = tid_l, wid = __builtin_amdgcn_readfirstlane(tid >> 6), lane = tid & 63, wr = wid >> 2, wc = wid & 3, fr = lane & 15, fq = lane >> 4;
    const int K = g.K, nt = K / BK;
    unsigned voffA[2], voffB[2];
#pragma unroll
    for (int i = 0; i < 2; ++i) { int R, C; stage_rc(tid * 16 + i * 8192, R, C); const int Rb = Epi::PERM ? ((R & ~31) + perm32(R & 31)) : R;
        voffA[i] = (unsigned)(R * K + C) * 2u; voffB[i] = (unsigned)(Rb * K + C) * 2u; }
    const size_t kstep = (size_t)(BK * 2);
    const size_t hstep = (size_t)HALF * K * 2;
    const size_t tstep = 2 * hstep;
    const unsigned ldsw = (unsigned)wid * 1024u;
    const int aoff = lds_byte(wr * 64 + fr, fq * 8), boff = lds_byte(wc * 32 + fr, fq * 8);
#define PG8_SA(b, h) (((b) * 2 + (h)) * HTB)
#define PG8_SB(b, h) ((4 + (b) * 2 + (h)) * HTB)
#define PG8_STAGE(bufoff, gbase, voff) do { _Pragma("unroll") for (int _i = 0; _i < 2; ++_i) \
        __builtin_amdgcn_global_load_lds((const unsigned*)((const char*)(gbase) + (voff)[_i]), (PG8_LAS unsigned*)(lds + (bufoff) + ldsw + _i * 8192), 16, 0, 0); } while (0)
#define PG8_LDA(dst, b, h) do { _Pragma("unroll") for (int m = 0; m < 4; ++m) _Pragma("unroll") for (int k = 0; k < 2; ++k) dst[m][k] = *(const PG8_LAS bf16x8*)(lds + PG8_SA(b, h) + aoff + m * 2048 + k * 1024); } while (0)
#define PG8_LDB(dst, b, h) do { _Pragma("unroll") for (int n = 0; n < 2; ++n) _Pragma("unroll") for (int k = 0; k < 2; ++k) dst[n][k] = *(const PG8_LAS bf16x8*)(lds + PG8_SB(b, h) + boff + n * 2048 + k * 1024); } while (0)
#define PG8_MMA(ai, bj, At, Bt) do { __builtin_amdgcn_s_setprio(1); _Pragma("unroll") for (int m = 0; m < 4; ++m) _Pragma("unroll") for (int n = 0; n < 2; ++n) _Pragma("unroll") for (int k = 0; k < 2; ++k) \
        acc[ai][bj][m][n] = __builtin_amdgcn_mfma_f32_16x16x32_bf16(Bt[n][k], At[m][k], acc[ai][bj][m][n], 0, 0, 0); __builtin_amdgcn_s_setprio(0); } while (0)
#define PG8_WAIT_V(n) asm volatile("s_waitcnt vmcnt(" #n ")" ::: "memory")
#define PG8_WAIT_L(n) asm volatile("s_waitcnt lgkmcnt(" #n ")" ::: "memory")
#define PG8_BAR __builtin_amdgcn_s_barrier()
#define PG8_SCHED __builtin_amdgcn_sched_barrier(0)
    Unit cur, nxt; int ui = 0;
    if (!S.next(0, cur)) return;
    f32x4 acc[2][2][4][2];
#pragma unroll
    for (int a = 0; a < 2; ++a)
#pragma unroll
        for (int b = 0; b < 2; ++b)
#pragma unroll
            for (int m = 0; m < 4; ++m)
#pragma unroll
                for (int n = 0; n < 2; ++n) acc[a][b][m][n] = (f32x4){0.f, 0.f, 0.f, 0.f};
    bf16x8 At[4][2], B0[2][2], B1[2][2];
    const char* cA = (const char*)g.A + (size_t)cur.pm * tstep; const char* cB = (const char*)g.Bt + (size_t)cur.pn * tstep;
    S.a_ready(cur);
    if constexpr (SP2) {
        PG8_STAGE(PG8_SB(0, 0), cB, voffB); PG8_STAGE(PG8_SB(0, 1), cB + hstep, voffB); PG8_STAGE(PG8_SA(0, 0), cA, voffA); PG8_STAGE(PG8_SA(0, 1), cA + hstep, voffA);
        if (wr == 1) PG8_BAR;
        PG8_WAIT_V(2); PG8_BAR;
        PG8_STAGE(PG8_SB(1, 0), cB + kstep, voffB); PG8_STAGE(PG8_SA(1, 0), cA + kstep, voffA); PG8_STAGE(PG8_SB(1, 1), cB + hstep + kstep, voffB);
        PG8_WAIT_V(6); PG8_BAR;
    } else {
        PG8_STAGE(PG8_SB(0, 0), cB, voffB); PG8_STAGE(PG8_SA(0, 0), cA, voffA); PG8_STAGE(PG8_SB(0, 1), cB + hstep, voffB); PG8_STAGE(PG8_SA(0, 1), cA + hstep, voffA);
        if (wr == 1) PG8_BAR;
        PG8_WAIT_V(4); PG8_BAR;
        PG8_STAGE(PG8_SB(1, 0), cB + kstep, voffB); PG8_STAGE(PG8_SA(1, 0), cA + kstep, voffA); PG8_STAGE(PG8_SB(1, 1), cB + hstep + kstep, voffB);
        PG8_WAIT_V(6); PG8_BAR;
    }
    for (;;) {
        const bool has_next = S.next(ui + 1, nxt);
        const char* nA = has_next ? (const char*)g.A + (size_t)nxt.pm * tstep : cA; const char* nB = has_next ? (const char*)g.Bt + (size_t)nxt.pn * tstep : cB;
#pragma unroll 1
        for (int t = 0; t < nt; t += 2) {
            const bool last = (t == nt - 2);
            const char* a1 = cA + (size_t)(t + 1) * kstep;
            const char* a2 = last ? nA : cA + (size_t)(t + 2) * kstep; const char* b2 = last ? nB : cB + (size_t)(t + 2) * kstep;
            const char* a3 = a2 + kstep; const char* b3 = b2 + kstep;
            if (last && has_next) S.a_ready(nxt);
            if constexpr (SP2) {
            PG8_LDB(B0, 0, 0); PG8_LDB(B1, 0, 1); PG8_SCHED; PG8_LDA(At, 0, 0); PG8_STAGE(PG8_SA(1, 1), a1 + hstep, voffA);
            PG8_WAIT_V(8); PG8_WAIT_L(0); PG8_BAR; PG8_MMA(0, 0, At, B0); PG8_MMA(0, 1, At, B1); PG8_BAR; PG8_SCHED;
            PG8_LDA(At, 0, 1); PG8_STAGE(PG8_SB(0, 0), b2, voffB); PG8_STAGE(PG8_SB(0, 1), b2 + hstep, voffB); PG8_STAGE(PG8_SA(0, 0), a2, voffA);
            PG8_WAIT_V(8); PG8_WAIT_L(0); PG8_BAR; PG8_MMA(1, 0, At, B0); PG8_MMA(1, 1, At, B1); PG8_BAR; PG8_SCHED;
            PG8_LDB(B0, 1, 0); PG8_LDB(B1, 1, 1); PG8_SCHED; PG8_LDA(At, 1, 0); PG8_STAGE(PG8_SA(0, 1), a2 + hstep, voffA);
            PG8_WAIT_V(8); PG8_WAIT_L(0); PG8_BAR; PG8_MMA(0, 0, At, B0); PG8_MMA(0, 1, At, B1); PG8_BAR; PG8_SCHED;
            PG8_LDA(At, 1, 1); PG8_STAGE(PG8_SB(1, 0), b3, voffB); PG8_STAGE(PG8_SB(1, 1), b3 + hstep, voffB); PG8_STAGE(PG8_SA(1, 0), a3, voffA);
            PG8_WAIT_V(8); PG8_WAIT_L(0); PG8_BAR; PG8_MMA(1, 0, At, B0); PG8_MMA(1, 1, At, B1); PG8_BAR; PG8_SCHED;
            } else {
            PG8_LDB(B0, 0, 0); PG8_SCHED; PG8_LDA(At, 0, 0); PG8_STAGE(PG8_SA(1, 1), a1 + hstep, voffA);
            PG8_WAIT_L(8); PG8_BAR; PG8_WAIT_L(0); PG8_MMA(0, 0, At, B0); PG8_BAR; PG8_SCHED;
            PG8_LDB(B1, 0, 1); PG8_STAGE(PG8_SB(0, 0), b2, voffB);
            PG8_BAR; PG8_WAIT_L(0); PG8_MMA(0, 1, At, B1); PG8_BAR;
            PG8_LDA(At, 0, 1); PG8_STAGE(PG8_SA(0, 0), a2, voffA);
            PG8_BAR; PG8_WAIT_L(0); PG8_MMA(1, 0, At, B0); PG8_BAR; PG8_SCHED;
            PG8_STAGE(PG8_SB(0, 1), b2 + hstep, voffB);
            PG8_WAIT_V(6); PG8_BAR; PG8_MMA(1, 1, At, B1); PG8_BAR;
            PG8_LDB(B0, 1, 0); PG8_SCHED; PG8_LDA(At, 1, 0); PG8_STAGE(PG8_SA(0, 1), a2 + hstep, voffA);
            PG8_WAIT_L(8); PG8_BAR; PG8_WAIT_L(0); PG8_MMA(0, 0, At, B0); PG8_BAR; PG8_SCHED;
            PG8_LDB(B1, 1, 1); PG8_STAGE(PG8_SB(1, 0), b3, voffB);
            PG8_BAR; PG8_WAIT_L(0); PG8_MMA(0, 1, At, B1); PG8_BAR;
            PG8_LDA(At, 1, 1); PG8_STAGE(PG8_SA(1, 0), a3, voffA);
            PG8_BAR; PG8_WAIT_L(0); PG8_MMA(1, 0, At, B0); PG8_BAR; PG8_SCHED;
            PG8_STAGE(PG8_SB(1, 1), b3 + hstep, voffB);
            PG8_WAIT_V(6); PG8_BAR; PG8_MMA(1, 1, At, B1); PG8_BAR;
            }
        }
        if constexpr (ALIGN_EPI) { if (wr == 0) PG8_BAR; }
        if constexpr (!Epi::AFTER_DRAIN) { E(acc, cur, wr, wc, fr, fq); S.done(cur); }
        if (!has_next) break;
#pragma unroll
        for (int a = 0; a < 2; ++a)
#pragma unroll
            for (int b = 0; b < 2; ++b)
#pragma unroll
                for (int m = 0; m < 4; ++m)
#pragma unroll
                    for (int n = 0; n < 2; ++n) acc[a][b][m][n] = (f32x4){0.f, 0.f, 0.f, 0.f};
        cur = nxt; cA = nA; cB = nB; ++ui;
        if constexpr (ALIGN_EPI) { if (wr == 1) PG8_BAR; }
    }
    PG8_WAIT_V(0);
    if constexpr (!ALIGN_EPI) { if (wr == 0) PG8_BAR; }
    PG8_BAR;
    if constexpr (Epi::AFTER_DRAIN) { E.fused(acc, cur, wr, wc, fr, fq, lds, wid, lane); S.done(cur); }
#undef PG8_SA
#undef PG8_SB
#undef PG8_STAGE
#undef PG8_LDA
#undef PG8_LDB
#undef PG8_MMA
#undef PG8_WAIT_V
#undef PG8_WAIT_L
#undef PG8_BAR
#undef PG8_SCHED
}
}

#define LAS __attribute__((address_space(3)))
using pg8::bf16_t; using pg8::bf16x8; using pg8::f32x4; using pg8::u32x4; using pg8::Unit; using pg8::cvt_pk_bf16;
typedef unsigned u32x2 __attribute__((ext_vector_type(2)));
typedef short s16x4 __attribute__((ext_vector_type(4)));
constexpr int T = 32768, SEQ = 2048, DM = 1024, NH = 4, QL = 384, KVL = 256, PW = 512, INW = 1216, FF = 4096;
constexpr int N1 = 1280;
constexpr float EPS = 1e-6f;
constexpr float QSCALE = 0.07216878364870322f * 1.4426950408889634f;
constexpr int NTHR = 512, NWAVES = 8;
constexpr int LDS_BYTES = 147456;

constexpr size_t MiB = 1u << 20;
constexpr size_t WS_WIN = 0, WS_WQ = 3 * MiB, WS_WK = 4 * MiB, WS_WV = 4 * MiB + 512 * 1024, WS_WO = 5 * MiB, WS_WUP = 7 * MiB, WS_WDN = 15 * MiB;
constexpr size_t WS_ROPE = 23 * MiB, WS_RSTDX = 31 * MiB, WS_SSQKV = 31 * MiB + 256 * 1024, WS_SSQQ = 32 * MiB, WS_SSQH = 33 * MiB, WS_SSQO = 35 * MiB;
constexpr size_t WS_HB = 40 * MiB, WS_XB = 104 * MiB, WS_CQ = 168 * MiB, WS_CKV = 192 * MiB, WS_KPE = 208 * MiB, WS_U = 212 * MiB, WS_Q = 244 * MiB, WS_KN = 292 * MiB,
                 WS_VT = 324 * MiB, WS_MIX = 356 * MiB, WS_ACT = 104 * MiB, WS_H2 = 360 * MiB, WS_END = 424 * MiB;
constexpr size_t WS_CTL = 38 * MiB, CTL_BYTES = 16384;

__device__ __forceinline__ float bf2f(unsigned short h) { return __uint_as_float((unsigned)h << 16); }
__device__ __forceinline__ u32x4 pack8(const f32x4 a, const f32x4 b) { u32x4 w; w.x = cvt_pk_bf16(a[0], a[1]); w.y = cvt_pk_bf16(a[2], a[3]); w.z = cvt_pk_bf16(b[0], b[1]); w.w = cvt_pk_bf16(b[2], b[3]); return w; }
__device__ __forceinline__ u32x2 pack4(const f32x4 a) { u32x2 w; w.x = cvt_pk_bf16(a[0], a[1]); w.y = cvt_pk_bf16(a[2], a[3]); return w; }
__device__ __forceinline__ float wave_sum(float v) {
#pragma unroll
    for (int o = 1; o < 64; o <<= 1) v += __shfl_xor(v, o);
    return v;
}
__device__ __forceinline__ float quad_fq_sum(float s) { s += __shfl_xor(s, 16); s += __shfl_xor(s, 32); return s; }
__device__ __forceinline__ float dot4(const f32x4 a) { return (a[0] * a[0] + a[1] * a[1]) + (a[2] * a[2] + a[3] * a[3]); }

__device__ __forceinline__ int ropeperm(int y) { const int w = y >> 5, rem = y & 31, fq = rem >> 3, n = (rem >> 2) & 1, j = rem & 3; return 16 * w + 4 * fq + j + 32 * n; }
__device__ __forceinline__ int cm_win(int g) { if (g < 256) return 384 + g; if (g < 512) return g - 256; if (g < 640) return 256 + (g - 512); if (g < 704) return 640 + ropeperm(g - 640); if (g < 768) return -1; return 704 + (g - 768); }
__device__ __forceinline__ int cm_wq(int g) { if (g < 512) return (g >> 7) * 192 + (g & 127); const int x = g - 512; return (x >> 6) * 192 + 128 + ropeperm(x & 63); }
__device__ __forceinline__ int cm_wk(int g) { return (g >> 7) * 256 + (g & 127); }
__device__ __forceinline__ int cm_wv(int g) { return (g >> 7) * 256 + 128 + (g & 127); }

__device__ __forceinline__ void rope4(const f32x4 x1, const f32x4 x2, const float* cs, f32x4& lo, f32x4& hi) {
    const f32x4 t0 = *(const f32x4*)cs, t1 = *(const f32x4*)(cs + 4);
    const f32x4 c = {t0[0], t0[2], t1[0], t1[2]}, s = {t0[1], t0[3], t1[1], t1[3]};
    lo = x1 * c - x2 * s; hi = x2 * c + x1 * s;
}

struct Epi1 {
    static constexpr bool PERM = true, AFTER_DRAIN = false;
    const float* rstd_x; const float* rope; bf16_t* Ckv; bf16_t* Cq; bf16_t* Kpe; bf16_t* U; float* ssq_kv; float* ssq_q;
    __device__ __forceinline__ void operator()(const f32x4 (&acc)[2][2][4][2], const Unit& u, int wr, int wc, int fr, int fq) const {
        const int pn = u.pn, c8 = wc * 32 + 8 * fq;
#pragma unroll
        for (int ai = 0; ai < 2; ++ai)
#pragma unroll
            for (int m = 0; m < 4; ++m) {
                const int row = u.pm * 256 + ai * 128 + wr * 64 + m * 16 + fr;
                const float rs = rstd_x[row];
                f32x4 v[2][2];
#pragma unroll
                for (int bj = 0; bj < 2; ++bj)
#pragma unroll
                    for (int n = 0; n < 2; ++n) v[bj][n] = acc[ai][bj][m][n] * rs;
                if (pn == 0) {
                    *(u32x4*)(Ckv + (size_t)row * KVL + c8) = pack8(v[0][0], v[0][1]); *(u32x4*)(Ckv + (size_t)row * KVL + 128 + c8) = pack8(v[1][0], v[1][1]);
                    const float s = quad_fq_sum((dot4(v[0][0]) + dot4(v[0][1])) + (dot4(v[1][0]) + dot4(v[1][1])));
                    if (fq == 0) ssq_kv[row * 4 + wc] = s;
                } else if (pn == 1) {
                    *(u32x4*)(Cq + (size_t)row * QL + c8) = pack8(v[0][0], v[0][1]); *(u32x4*)(Cq + (size_t)row * QL + 128 + c8) = pack8(v[1][0], v[1][1]);
                    const float s = quad_fq_sum((dot4(v[0][0]) + dot4(v[0][1])) + (dot4(v[1][0]) + dot4(v[1][1])));
                    if (fq == 0) ssq_q[row * 8 + wc] = s;
                } else if (pn == 2) {
                    *(u32x4*)(Cq + (size_t)row * QL + 256 + c8) = pack8(v[0][0], v[0][1]);
                    const float s = quad_fq_sum(dot4(v[0][0]) + dot4(v[0][1]));
                    if (fq == 0) ssq_q[row * 8 + 4 + wc] = s;
                    if (wc < 2) { const int i0 = 16 * wc + 4 * fq; f32x4 lo, hi; rope4(v[1][0], v[1][1], rope + (size_t)row * 64 + 2 * i0, lo, hi);
                        *(u32x2*)(Kpe + (size_t)row * 64 + i0) = pack4(lo); *(u32x2*)(Kpe + (size_t)row * 64 + 32 + i0) = pack4(hi); }
                } else {
                    bf16_t* d = U + (size_t)row * PW + (pn - 3) * 256 + c8;
                    *(u32x4*)d = pack8(v[0][0], v[0][1]); *(u32x4*)(d + 128) = pack8(v[1][0], v[1][1]);
                }
                asm volatile("" ::: "memory");
            }
    }
};
struct Epi2 {
    static constexpr bool PERM = true, AFTER_DRAIN = false;
    const float* ssq_q; const float* rope; bf16_t* Q;
    __device__ __forceinline__ void operator()(const f32x4 (&acc)[2][2][4][2], const Unit& u, int wr, int wc, int fr, int fq) const {
        const int pn = u.pn, c8 = wc * 32 + 8 * fq;
#pragma unroll
        for (int ai = 0; ai < 2; ++ai)
#pragma unroll
            for (int m = 0; m < 4; ++m) {
                const int row = u.pm * 256 + ai * 128 + wr * 64 + m * 16 + fr;
                const f32x4 p0 = *(const f32x4*)(ssq_q + row * 8), p1 = *(const f32x4*)(ssq_q + row * 8 + 4);
                const float rs = rsqrtf(((p0[0] + p0[1]) + (p0[2] + p0[3]) + (p1[0] + p1[1]) + (p1[2] + p1[3])) * (1.0f / QL) + EPS) * QSCALE;
                bf16_t* qrow = Q + (size_t)row * 768;
#pragma unroll
                for (int bj = 0; bj < 2; ++bj) {
                    const f32x4 v0 = acc[ai][bj][m][0] * rs, v1 = acc[ai][bj][m][1] * rs;
                    if (pn < 2) { *(u32x4*)(qrow + (pn * 2 + bj) * 192 + c8) = pack8(v0, v1); }
                    else { const int head = 2 * bj + (wc >> 1), i0 = 16 * (wc & 1) + 4 * fq; f32x4 lo, hi; rope4(v0, v1, rope + (size_t)row * 64 + 2 * i0, lo, hi);
                        *(u32x2*)(qrow + head * 192 + 128 + i0) = pack4(lo); *(u32x2*)(qrow + head * 192 + 160 + i0) = pack4(hi); }
                }
                asm volatile("" ::: "memory");
            }
    }
};
struct Epi3a {
    static constexpr bool PERM = true, AFTER_DRAIN = false;
    const float* ssq_kv; bf16_t* Kn;
    __device__ __forceinline__ void operator()(const f32x4 (&acc)[2][2][4][2], const Unit& u, int wr, int wc, int fr, int fq) const {
        const int c8 = u.pn * 256 + wc * 32 + 8 * fq;
#pragma unroll
        for (int ai = 0; ai < 2; ++ai)
#pragma unroll
            for (int m = 0; m < 4; ++m) {
                const int row = u.pm * 256 + ai * 128 + wr * 64 + m * 16 + fr;
                const f32x4 p0 = *(const f32x4*)(ssq_kv + row * 4);
                const float rs = rsqrtf(((p0[0] + p0[1]) + (p0[2] + p0[3])) * (1.0f / KVL) + EPS);
#pragma unroll
                for (int bj = 0; bj < 2; ++bj) *(u32x4*)(Kn + (size_t)row * 512 + bj * 128 + c8) = pack8(acc[ai][bj][m][0] * rs, acc[ai][bj][m][1] * rs);
                asm volatile("" ::: "memory");
            }
    }
};
struct Epi3b {
    static constexpr bool PERM = true, AFTER_DRAIN = false;
    const float* ssq_kv; bf16_t* Vt;
    __device__ __forceinline__ void operator()(const f32x4 (&acc)[2][2][4][2], const Unit& u, int wr, int wc, int fr, int fq) const {
        const int t8 = u.pn * 256 + wc * 32 + 8 * fq;
#pragma unroll
        for (int bj = 0; bj < 2; ++bj) {
            f32x4 rs[2];
#pragma unroll
            for (int e = 0; e < 8; ++e) { const f32x4 p0 = *(const f32x4*)(ssq_kv + (size_t)(t8 + bj * 128 + e) * 4);
                rs[e >> 2][e & 3] = rsqrtf(((p0[0] + p0[1]) + (p0[2] + p0[3])) * (1.0f / KVL) + EPS); }
#pragma unroll
            for (int ai = 0; ai < 2; ++ai)
#pragma unroll
                for (int m = 0; m < 4; ++m) {
                    const int hv = u.pm * 256 + ai * 128 + wr * 64 + m * 16 + fr;
                    *(u32x4*)(Vt + (size_t)hv * T + bj * 128 + t8) = pack8(acc[ai][bj][m][0] * rs[0], acc[ai][bj][m][1] * rs[1]);
                }
            asm volatile("" ::: "memory");
        }
    }
};
__device__ __forceinline__ void unpack8(const u32x4 r, f32x4& a, f32x4& b) {
    a = (f32x4){__uint_as_float(r[0] << 16), __uint_as_float(r[0] & 0xffff0000u), __uint_as_float(r[1] << 16), __uint_as_float(r[1] & 0xffff0000u)};
    b = (f32x4){__uint_as_float(r[2] << 16), __uint_as_float(r[2] & 0xffff0000u), __uint_as_float(r[3] << 16), __uint_as_float(r[3] & 0xffff0000u)};
}
struct Epi4 {
    static constexpr bool PERM = true, AFTER_DRAIN = false;
    const bf16_t* Xb; bf16_t* Hb; float* ssq_h;
    __device__ __forceinline__ void operator()(const f32x4 (&acc)[2][2][4][2], const Unit& u, int wr, int wc, int fr, int fq) const {
        const int c8 = u.pn * 256 + wc * 32 + 8 * fq;
#pragma unroll
        for (int ai = 0; ai < 2; ++ai)
#pragma unroll
            for (int m = 0; m < 4; ++m) {
                const int row = u.pm * 256 + ai * 128 + wr * 64 + m * 16 + fr;
                float s = 0.f;
#pragma unroll
                for (int bj = 0; bj < 2; ++bj) { const size_t off = (size_t)row * DM + bj * 128 + c8;
                    f32x4 x0, x1; unpack8(*(const u32x4*)(Xb + off), x0, x1);
                    const f32x4 h0 = x0 + acc[ai][bj][m][0], h1 = x1 + acc[ai][bj][m][1];
                    *(u32x4*)(Hb + off) = pack8(h0, h1); s += dot4(h0) + dot4(h1); }
                s = quad_fq_sum(s);
                if (fq == 0) ssq_h[row * 16 + u.pn * 4 + wc] = s;
                asm volatile("" ::: "memory");
            }
    }
};
struct Epi5 {
    static constexpr bool PERM = true, AFTER_DRAIN = false;
    const float* ssq_h; bf16_t* Act;
    __device__ __forceinline__ void operator()(const f32x4 (&acc)[2][2][4][2], const Unit& u, int wr, int wc, int fr, int fq) const {
        const int c8 = u.pn * 256 + wc * 32 + 8 * fq;
#pragma unroll
        for (int ai = 0; ai < 2; ++ai)
#pragma unroll
            for (int m = 0; m < 4; ++m) {
                const int row = u.pm * 256 + ai * 128 + wr * 64 + m * 16 + fr;
                const f32x4 p0 = *(const f32x4*)(ssq_h + row * 16), p1 = *(const f32x4*)(ssq_h + row * 16 + 4), p2 = *(const f32x4*)(ssq_h + row * 16 + 8), p3 = *(const f32x4*)(ssq_h + row * 16 + 12);
                const f32x4 ps = (p0 + p1) + (p2 + p3);
                const float rs = rsqrtf(((ps[0] + ps[1]) + (ps[2] + ps[3])) * (1.0f / DM) + EPS);
#pragma unroll
                for (int bj = 0; bj < 2; ++bj) { f32x4 v0 = acc[ai][bj][m][0] * rs, v1 = acc[ai][bj][m][1] * rs;
#pragma unroll
                    for (int e = 0; e < 4; ++e) { const float a = fmaxf(v0[e], 0.f), b = fmaxf(v1[e], 0.f); v0[e] = a * a; v1[e] = b * b; }
                    *(u32x4*)(Act + (size_t)row * FF + bj * 128 + c8) = pack8(v0, v1); }
                asm volatile("" ::: "memory");
            }
    }
};
struct Epi6 {
    static constexpr bool PERM = true, AFTER_DRAIN = false;
    const bf16_t* Hb; bf16_t* H2b; float* ssq_o;
    __device__ __forceinline__ void operator()(const f32x4 (&acc)[2][2][4][2], const Unit& u, int wr, int wc, int fr, int fq) const {
        const int c8 = u.pn * 256 + wc * 32 + 8 * fq;
#pragma unroll
        for (int ai = 0; ai < 2; ++ai)
#pragma unroll
            for (int m = 0; m < 4; ++m) {
                const int row = u.pm * 256 + ai * 128 + wr * 64 + m * 16 + fr;
                float s = 0.f;
#pragma unroll
                for (int bj = 0; bj < 2; ++bj) { const size_t off = (size_t)row * DM + bj * 128 + c8;
                    f32x4 x0, x1; unpack8(*(const u32x4*)(Hb + off), x0, x1);
                    const f32x4 h0 = x0 + acc[ai][bj][m][0], h1 = x1 + acc[ai][bj][m][1];
                    *(u32x4*)(H2b + off) = pack8(h0, h1); s += dot4(h0) + dot4(h1); }
                s = quad_fq_sum(s);
                if (fq == 0) ssq_o[row * 16 + u.pn * 4 + wc] = s;
                asm volatile("" ::: "memory");
            }
    }
};

#define LDS_WAIT() asm volatile("s_waitcnt lgkmcnt(0)" ::: "memory")
template <int MAT>
__device__ __forceinline__ void tr_item(const float* __restrict__ W, int ldw, const float* __restrict__ gain, bf16_t* __restrict__ WT, int ldd, int nblk, LAS float* scr, int item, int lane) {
    const int kb = item / nblk, nb = item % nblk, k0 = 64 * kb, n0 = 32 * nb, gcol = n0 + (lane & 31);
    const int sc = MAT == 0 ? cm_win(gcol) : MAT == 1 ? cm_wq(gcol) : MAT == 2 ? cm_wk(gcol) : MAT == 3 ? cm_wv(gcol) : gcol;
#pragma unroll 8
    for (int i = 0; i < 32; ++i) { const int kk = 2 * i + (lane >> 5); float v = 0.f;
        if (sc >= 0) { v = W[(size_t)(k0 + kk) * ldw + sc]; if (gain) v *= gain[k0 + kk]; }
        scr[kk * 33 + (lane & 31)] = v; }
    LDS_WAIT(); asm volatile("" ::: "memory");
    const int c = lane & 7;
#pragma unroll
    for (int j = 0; j < 4; ++j) { const int n = (lane >> 3) + 8 * j; const LAS float* s = scr + (8 * c) * 33 + n;
        u32x4 o; o.x = cvt_pk_bf16(s[0 * 33], s[1 * 33]); o.y = cvt_pk_bf16(s[2 * 33], s[3 * 33]); o.z = cvt_pk_bf16(s[4 * 33], s[5 * 33]); o.w = cvt_pk_bf16(s[6 * 33], s[7 * 33]);
        *(u32x4*)(WT + (size_t)(n0 + n) * ldd + k0 + 8 * c) = o; }
    LDS_WAIT(); asm volatile("" ::: "memory");
}

template <int W>
__device__ __forceinline__ void pool_item(const bf16_t* __restrict__ U, bf16_t* __restrict__ Mix, int chunk, int gg, int lane) {
    const int sub = lane >> 4, c = lane & 15, r0 = chunk * 32 + sub * 8, s0 = r0 & (SEQ - 1);
    const bf16_t* up = U + (size_t)r0 * PW + gg * 128 + c * 8;
    u32x4 raw[W + 7];
#pragma unroll
    for (int j = 0; j < W + 7; ++j) { const int dj = j - (W - 1); raw[j] = (s0 + dj >= 0) ? *(const u32x4*)(up + (long)dj * PW) : (u32x4){0u, 0u, 0u, 0u}; }
    float S[8];
#pragma unroll
    for (int e = 0; e < 8; ++e) S[e] = 0.f;
#pragma unroll
    for (int j = 0; j < W; ++j)
#pragma unroll
        for (int e = 0; e < 4; ++e) { S[2 * e] += __uint_as_float(raw[j][e] << 16); S[2 * e + 1] += __uint_as_float(raw[j][e] & 0xffff0000u); }
    bf16_t* op = Mix + (size_t)r0 * DM + 512 + gg * 128 + c * 8;
#pragma unroll
    for (int i = 0; i < 8; ++i) {
        const int cnt = (s0 + i + 1 < W) ? s0 + i + 1 : W; const float ic = 1.0f / (float)cnt;
        const u32x4 cur = raw[i + W - 1]; u32x4 o;
#pragma unroll
        for (int e = 0; e < 4; ++e) o[e] = cvt_pk_bf16(S[2 * e] * ic - __uint_as_float(cur[e] << 16), S[2 * e + 1] * ic - __uint_as_float(cur[e] & 0xffff0000u));
        *(u32x4*)(op + (size_t)i * DM) = o;
        if (i < 7) {
#pragma unroll
            for (int e = 0; e < 4; ++e) { S[2 * e] += __uint_as_float(raw[i + W][e] << 16) - __uint_as_float(raw[i][e] << 16); S[2 * e + 1] += __uint_as_float(raw[i + W][e] & 0xffff0000u) - __uint_as_float(raw[i][e] & 0xffff0000u); }
        }
    }
}

constexpr int KN_B = 64 * 256, KR_B = 64 * 128, VT_B = 128 * 128, STG_B = KN_B + KR_B + VT_B;
static_assert(2 * STG_B <= 131072, "attention LDS");

__device__ __forceinline__ void attn_unit(LAS unsigned char* lds, const bf16_t* __restrict__ Q, const bf16_t* __restrict__ Kn, const bf16_t* __restrict__ Kpe,
                                          const bf16_t* __restrict__ Vt, bf16_t* __restrict__ Mix, int b, int h, int qb, int tid, int wid, int lane_in) {
    int lane = lane_in; asm volatile("" : "+v"(lane));
    const int fr = lane & 15, g = lane >> 4;
    const int q0 = qb * 256 + wid * 32;
    const size_t rb = (size_t)b * SEQ;
    bf16x8 qf[2][6];
#pragma unroll
    for (int q2 = 0; q2 < 2; ++q2)
#pragma unroll
        for (int ks = 0; ks < 6; ++ks) qf[q2][ks] = *(const bf16x8*)(Q + (rb + q0 + 16 * q2 + fr) * 768 + h * 192 + 32 * ks + 8 * g);
    f32x4 o[8][2];
#pragma unroll
    for (int vb = 0; vb < 8; ++vb) { o[vb][0] = (f32x4){0.f, 0.f, 0.f, 0.f}; o[vb][1] = (f32x4){0.f, 0.f, 0.f, 0.f}; }
    float mrun[2] = {-INFINITY, -INFINITY}, lrun[2] = {0.f, 0.f};
    const int nt = 4 * (qb + 1);
    unsigned oN[2], oV[2], oR;
#pragma unroll
    for (int r = 0; r < 2; ++r) { const int L = (r * 8 + wid) * 64 + lane;
        { const int key = L >> 4, pc = L & 15, cc = pc ^ (key & 15); oN[r] = (unsigned)(key * 1024 + cc * 16); }
        { const int vd = L >> 3, pc = L & 7, cc = pc ^ ((vd >> 1) & 7); oV[r] = (unsigned)(vd * (T * 2) + cc * 16); } }
    { const int L = wid * 64 + lane, key = L >> 3, pc = L & 7, cc = pc ^ ((key >> 1) & 7); oR = (unsigned)(key * 128 + cc * 16); }
    const char* bN = (const char*)(Kn + rb * 512 + h * 128); const char* bR = (const char*)(Kpe + rb * 64); const char* bV = (const char*)(Vt + (size_t)(h * 128) * T + rb);
#define ATT_DMA(kt, buf) do { LAS unsigned char* _d = lds + (buf) * STG_B; const char* _n = bN + (size_t)(kt) * (64 * 512 * 2); const char* _r = bR + (size_t)(kt) * (64 * 64 * 2); const char* _v = bV + (size_t)(kt) * 128; \
        __builtin_amdgcn_global_load_lds((const unsigned*)(_n + oN[0]), (LAS unsigned*)(_d + wid * 1024), 16, 0, 0); \
        __builtin_amdgcn_global_load_lds((const unsigned*)(_n + oN[1]), (LAS unsigned*)(_d + 8192 + wid * 1024), 16, 0, 0); \
        __builtin_amdgcn_global_load_lds((const unsigned*)(_r + oR), (LAS unsigned*)(_d + KN_B + wid * 1024), 16, 0, 0); \
        __builtin_amdgcn_global_load_lds((const unsigned*)(_v + oV[0]), (LAS unsigned*)(_d + KN_B + KR_B + wid * 1024), 16, 0, 0); \
        __builtin_amdgcn_global_load_lds((const unsigned*)(_v + oV[1]), (LAS unsigned*)(_d + KN_B + KR_B + 8192 + wid * 1024), 16, 0, 0); } while (0)
    const int swr = (fr >> 1) & 7;
    const int aN = fr * 256 + ((g ^ fr) << 4);
    const int aR = KN_B + fr * 128 + ((g ^ swr) << 4);
    const int aV = KN_B + KR_B + fr * 128 + (((g >> 1) ^ swr) << 4) + (g & 1) * 8;
    ATT_DMA(0, 0);
    asm volatile("s_waitcnt vmcnt(0)" ::: "memory");
    __syncthreads();
    for (int kt = 0; kt < nt; ++kt) {
        const int buf = kt & 1;
        if (kt + 1 < nt) ATT_DMA(kt + 1, buf ^ 1);
        if (kt * 64 <= q0 + 31) {
            LAS unsigned char* Sb = lds + buf * STG_B;
            f32x4 s[4][2];
#pragma unroll
            for (int kb = 0; kb < 4; ++kb) { s[kb][0] = (f32x4){0.f, 0.f, 0.f, 0.f}; s[kb][1] = (f32x4){0.f, 0.f, 0.f, 0.f}; }
#pragma unroll
            for (int ks = 0; ks < 6; ++ks) {
                bf16x8 kf[4];
#pragma unroll
                for (int kb = 0; kb < 4; ++kb) kf[kb] = (ks < 4) ? *(const LAS bf16x8*)(Sb + (aN ^ (ks * 64)) + kb * 4096) : *(const LAS bf16x8*)(Sb + (aR ^ ((ks - 4) * 64)) + kb * 2048);
#pragma unroll
                for (int kb = 0; kb < 4; ++kb) {
                    s[kb][0] = __builtin_amdgcn_mfma_f32_16x16x32_bf16(kf[kb], qf[0][ks], s[kb][0], 0, 0, 0);
                    s[kb][1] = __builtin_amdgcn_mfma_f32_16x16x32_bf16(kf[kb], qf[1][ks], s[kb][1], 0, 0, 0); }
            }
            if (kt * 64 + 63 > q0) {
#pragma unroll
                for (int q2 = 0; q2 < 2; ++q2) { const int qi = q0 + 16 * q2 + fr;
#pragma unroll
                    for (int kb = 0; kb < 4; ++kb)
#pragma unroll
                        for (int i = 0; i < 4; ++i) if (kt * 64 + 16 * kb + 4 * g + i > qi) s[kb][q2][i] = -INFINITY; }
            }
            bf16x8 pb[2][2];
#pragma unroll
            for (int q2 = 0; q2 < 2; ++q2) {
                float mx = fmaxf(fmaxf(s[0][q2][0], s[0][q2][1]), fmaxf(s[0][q2][2], s[0][q2][3]));
#pragma unroll
                for (int kb = 1; kb < 4; ++kb) mx = fmaxf(mx, fmaxf(fmaxf(s[kb][q2][0], s[kb][q2][1]), fmaxf(s[kb][q2][2], s[kb][q2][3])));
                mx = fmaxf(mx, __shfl_xor(mx, 16)); mx = fmaxf(mx, __shfl_xor(mx, 32));
                const float mnew = fmaxf(mrun[q2], mx), alpha = __builtin_amdgcn_exp2f(mrun[q2] - mnew);
                mrun[q2] = mnew;
                float rsum = 0.f;
#pragma unroll
                for (int kb = 0; kb < 4; ++kb)
#pragma unroll
                    for (int i = 0; i < 4; ++i) { const float p = __builtin_amdgcn_exp2f(s[kb][q2][i] - mnew); s[kb][q2][i] = p; rsum += p; }
                lrun[q2] = lrun[q2] * alpha + rsum;
#pragma unroll
                for (int vb = 0; vb < 8; ++vb) o[vb][q2] = o[vb][q2] * alpha;
#pragma unroll
                for (int k2 = 0; k2 < 2; ++k2) { const u32x4 w = pack8(s[2 * k2][q2], s[2 * k2 + 1][q2]); pb[q2][k2] = __builtin_bit_cast(bf16x8, w); }
            }
#pragma unroll
            for (int k2 = 0; k2 < 2; ++k2)
#pragma unroll
                for (int vq = 0; vq < 2; ++vq) {
                    bf16x8 vf[4];
#pragma unroll
                    for (int v4 = 0; v4 < 4; ++v4) { const LAS unsigned char* vp = Sb + (aV ^ (k2 * 64)) + (4 * vq + v4) * 2048; const LAS unsigned char* vph = Sb + (aV ^ (k2 * 64) ^ 32) + (4 * vq + v4) * 2048;
                        const s16x4 lo = *(const LAS s16x4*)vp, hi = *(const LAS s16x4*)vph;
                        vf[v4] = (bf16x8){lo[0], lo[1], lo[2], lo[3], hi[0], hi[1], hi[2], hi[3]}; }
#pragma unroll
                    for (int v4 = 0; v4 < 4; ++v4) {
                        o[4 * vq + v4][0] = __builtin_amdgcn_mfma_f32_16x16x32_bf16(vf[v4], pb[0][k2], o[4 * vq + v4][0], 0, 0, 0);
                        o[4 * vq + v4][1] = __builtin_amdgcn_mfma_f32_16x16x32_bf16(vf[v4], pb[1][k2], o[4 * vq + v4][1], 0, 0, 0); }
                }
        }
        asm volatile("s_waitcnt vmcnt(0)" ::: "memory");
        __syncthreads();
    }
#undef ATT_DMA
#pragma unroll
    for (int q2 = 0; q2 < 2; ++q2) {
        const float l = quad_fq_sum(lrun[q2]), inv = 1.0f / l;
        bf16_t* orow = Mix + (rb + q0 + 16 * q2 + fr) * DM + h * 128 + 4 * g;
#pragma unroll
        for (int vb = 0; vb < 8; ++vb) *(u32x2*)(orow + 16 * vb) = pack4(o[vb][q2] * inv);
    }
}

#define XB_TMO      128
#define XB_XCNT(j)  (256  + 64 * (j))
#define XB_XSUB(j)  (1280 + 64 * (j))
#define XB_XGEN(j)  (2304 + 64 * (j))
#define XB_TOP      3328
#define XB_TOPGEN   3392
#define XCD_BAR_WORDS 3456
#define XB_SPIN_CAP (1u << 18)

__device__ __forceinline__ unsigned xb_ld(unsigned* p)              { return __hip_atomic_load(p, __ATOMIC_RELAXED, __HIP_MEMORY_SCOPE_AGENT); }
__device__ __forceinline__ unsigned xb_add(unsigned* p, unsigned v) { return __hip_atomic_fetch_add(p, v, __ATOMIC_RELAXED, __HIP_MEMORY_SCOPE_AGENT); }
__device__ __forceinline__ unsigned xb_xcc_id() { return (unsigned)__builtin_amdgcn_s_getreg((3 << 11) | 20) & 0xFu; }
#define XB_SPIN(cond, bar) do { unsigned _sp = 0; while (cond) { __builtin_amdgcn_s_sleep(1); \
    if ((++_sp & 255u) == 0u) { if (xb_ld(&(bar)[XB_TMO])) break; if (_sp > XB_SPIN_CAP) { atomicAdd(&(bar)[XB_TMO], 1u); break; } } } } while (0)

struct XcdBarrier {
    unsigned* bar; unsigned x;
    volatile LAS unsigned* st;
};

__device__ __forceinline__ XcdBarrier xcd_barrier_post(unsigned* bar, volatile LAS unsigned* st) {
    XcdBarrier b; b.bar = bar; b.x = xb_xcc_id(); b.st = st;
    if (threadIdx.x == 0) (void)xb_add(&bar[XB_XCNT(b.x)], 1u);
    return b;
}
__device__ __forceinline__ void xcd_barrier_complete(unsigned* bar, unsigned x, unsigned& nloc, unsigned& nx) {
    const unsigned G = gridDim.x * gridDim.y * gridDim.z;
    unsigned sum, cnt, mine, sp = 0u;
    for (;;) {
        sum = 0u; cnt = 0u; mine = 0u;
#pragma unroll
        for (unsigned j = 0; j < 16; ++j) { const unsigned c = xb_ld(&bar[XB_XCNT(j)]); sum += c; cnt += (c > 0u) ? 1u : 0u; mine = (j == x) ? c : mine; }
        if (sum == G) break;
        __builtin_amdgcn_s_sleep(1);
        if ((++sp & 255u) == 0u) { if (xb_ld(&bar[XB_TMO])) break; if (sp > XB_SPIN_CAP) { atomicAdd(&bar[XB_TMO], 1u); break; } }
    }
    nloc = mine > 0u ? mine : 1u; nx = cnt > 0u ? cnt : 1u;
}

__device__ __forceinline__ void xcd_barrier(const XcdBarrier& b) {
    asm volatile("s_waitcnt vmcnt(0)" ::: "memory");
    __syncthreads();
    if (threadIdx.x == 0) {
        unsigned* bar = b.bar;
        __builtin_amdgcn_s_waitcnt(0);
        unsigned nloc = b.st[0], nx = b.st[1];
        if (nloc == 0u) { xcd_barrier_complete(bar, b.x, nloc, nx); b.st[0] = nloc; b.st[1] = nx; }
        const unsigned old = xb_add(&bar[XB_XSUB(b.x)], 1u);
        const unsigned gen = old / nloc;
        if (old + 1u == (gen + 1u) * nloc) {
            __builtin_amdgcn_fence(__ATOMIC_RELEASE, "agent");
            asm volatile("s_waitcnt vmcnt(0)" ::: "memory");
            const unsigned og = xb_add(&bar[XB_TOP], 1u);
            const unsigned tg = og / nx;
            if (og + 1u == (tg + 1u) * nx) xb_add(&bar[XB_TOPGEN], 1u);
            else XB_SPIN(xb_ld(&bar[XB_TOPGEN]) == tg, bar);
            __builtin_amdgcn_fence(__ATOMIC_ACQUIRE, "agent");
            xb_add(&bar[XB_XGEN(b.x)], 1u);
            asm volatile("s_waitcnt vmcnt(0)" ::: "memory");
        } else {
            XB_SPIN(xb_ld(&bar[XB_XGEN(b.x)]) == gen, bar);
            __builtin_amdgcn_fence(__ATOMIC_ACQUIRE, "agent");
            asm volatile("s_waitcnt vmcnt(0)" ::: "memory");
        }
    }
    __syncthreads();
}

#ifndef REPMASK
#define REPMASK 0
#endif
struct Args { const float* in[15]; float* out; unsigned char* ws; };
__global__ void __launch_bounds__(NTHR, 2) mk_fwd(Args a) {
    extern __shared__ __attribute__((aligned(16))) unsigned char lds_raw[];
    LAS unsigned char* lds = (LAS unsigned char*)lds_raw;
    cg::grid_group grid = cg::this_grid();
    const int tid = threadIdx.x, lane = tid & 63, wid = __builtin_amdgcn_readfirstlane(tid >> 6);
    const int G = gridDim.x, bx = blockIdx.x, vcu = (G % 8 == 0) ? (bx % 8) * (G / 8) + bx / 8 : bx;
    const int gw = vcu * NWAVES + wid, NGW = G * NWAVES, gtid = bx * NTHR + tid, NT = G * NTHR;
    unsigned char* ws = a.ws;
    volatile LAS unsigned* MISC = (volatile LAS unsigned*)(lds + 131072);
    if (tid < 64) MISC[tid] = 0u;
    __syncthreads();
    XcdBarrier xbar = xcd_barrier_post((unsigned*)(ws + WS_CTL), MISC + 8);
    const float* x = a.in[0]; const int* pos = (const int*)a.in[1]; const float* g_mix = a.in[2]; const float* w_in = a.in[3]; const float* g_q = a.in[4]; const float* w_q = a.in[5];
    const float* g_kv = a.in[6]; const float* w_kv = a.in[7]; const float* pool_w = a.in[8]; const float* pool_s = a.in[9]; const float* w_out = a.in[10]; const float* g_mlp = a.in[11];
    const float* w_up = a.in[12]; const float* w_dn = a.in[13]; const float* g_fin = a.in[14]; float* out = a.out;
    bf16_t* Win_t = (bf16_t*)(ws + WS_WIN); bf16_t* Wq_t = (bf16_t*)(ws + WS_WQ); bf16_t* Wk_t = (bf16_t*)(ws + WS_WK); bf16_t* Wv_t = (bf16_t*)(ws + WS_WV); bf16_t* Wo_t = (bf16_t*)(ws + WS_WO);
    bf16_t* Wup_t = (bf16_t*)(ws + WS_WUP); bf16_t* Wdn_t = (bf16_t*)(ws + WS_WDN);
    float* rope = (float*)(ws + WS_ROPE); float* rstd_x = (float*)(ws + WS_RSTDX); float* ssq_kv = (float*)(ws + WS_SSQKV); float* ssq_q = (float*)(ws + WS_SSQQ);
    float* ssq_h = (float*)(ws + WS_SSQH); float* ssq_o = (float*)(ws + WS_SSQO);
    bf16_t* Hb = (bf16_t*)(ws + WS_HB); bf16_t* Xb = (bf16_t*)(ws + WS_XB); bf16_t* Cq = (bf16_t*)(ws + WS_CQ); bf16_t* Ckv = (bf16_t*)(ws + WS_CKV); bf16_t* Kpe = (bf16_t*)(ws + WS_KPE);
    bf16_t* U = (bf16_t*)(ws + WS_U); bf16_t* Qb = (bf16_t*)(ws + WS_Q); bf16_t* Kn = (bf16_t*)(ws + WS_KN); bf16_t* Vt = (bf16_t*)(ws + WS_VT); bf16_t* Mix = (bf16_t*)(ws + WS_MIX);
    bf16_t* Act = (bf16_t*)(ws + WS_ACT); bf16_t* H2b = (bf16_t*)(ws + WS_H2);

    for (int rep_ = 0; rep_ <= ((REPMASK >> 0) & 1); ++rep_) {
    {
        LAS float* scr = (LAS float*)(lds + wid * 16384);
        constexpr int I_IN = 16 * (N1 / 32), I_Q = 6 * 24, I_K = 4 * 16, I_V = 4 * 16, I_O = 8 * 32, I_UP = 16 * 128, I_DN = 64 * 32;
        constexpr int NITEMS = I_IN + I_Q + I_K + I_V + I_O + I_UP + I_DN;
        for (int it = gw; it < NITEMS; it += NGW) {
            int r = it;
            if (r < I_UP) { tr_item<4>(w_up, FF, g_mlp, Wup_t, DM, FF / 32, scr, r, lane); continue; } r -= I_UP;
            if (r < I_DN) { tr_item<4>(w_dn, DM, nullptr, Wdn_t, FF, DM / 32, scr, r, lane); continue; } r -= I_DN;
            if (r < I_IN) { tr_item<0>(w_in, INW, g_mix, Win_t, DM, N1 / 32, scr, r, lane); continue; } r -= I_IN;
            if (r < I_Q) { tr_item<1>(w_q, 768, g_q, Wq_t, QL, 24, scr, r, lane); continue; } r -= I_Q;
            if (r < I_K) { tr_item<2>(w_kv, 1024, g_kv, Wk_t, KVL, 16, scr, r, lane); continue; } r -= I_K;
            if (r < I_V) { tr_item<3>(w_kv, 1024, g_kv, Wv_t, KVL, 16, scr, r, lane); continue; } r -= I_V;
            tr_item<4>(w_out, DM, nullptr, Wo_t, DM, 32, scr, r, lane);
        }
        for (int wi = gw; wi < 1024; wi += NGW) {
            const int nb = wi & 15, c8 = (wi >> 4) & 15, gg = wi >> 8, n = nb * 64 + lane;
            float accv[8];
#pragma unroll
            for (int cc = 0; cc < 8; ++cc) accv[cc] = 0.f;
            const float* pw = pool_w + (size_t)(gg * 128 + c8 * 8) * 128; const float* ps = pool_s + gg * 128; const float* wo = w_out + (size_t)(512 + gg * 128) * DM + n;
#pragma unroll 16
            for (int d = 0; d < 128; ++d) { const float wv = wo[(size_t)d * DM] * ps[d];
#pragma unroll
                for (int cc = 0; cc < 8; ++cc) accv[cc] += pw[cc * 128 + d] * wv; }
            u32x4 o; o.x = cvt_pk_bf16(accv[0], accv[1]); o.y = cvt_pk_bf16(accv[2], accv[3]); o.z = cvt_pk_bf16(accv[4], accv[5]); o.w = cvt_pk_bf16(accv[6], accv[7]);
            *(u32x4*)(Wo_t + (size_t)n * DM + 512 + gg * 128 + c8 * 8) = o;
        }
        for (int it = gtid; it < T * 32; it += NT) {
            const int row = it >> 5, i = it & 31;
            const float inv = exp2f(-(float)i * (13.287712379549449f / 32.0f));
            const float ang = (float)pos[row] * inv;
            double rev = (double)ang * 0.15915494309189535; rev -= rint(rev);
            const float fr_ = (float)rev;
            rope[2 * it] = __builtin_amdgcn_cosf(fr_); rope[2 * it + 1] = __builtin_amdgcn_sinf(fr_);
        }
        for (int row = gw; row < T; row += NGW) {
            const f32x4* xr = (const f32x4*)(x + (size_t)row * DM) + lane;
            f32x4 v[4]; float s = 0.f;
#pragma unroll
            for (int j = 0; j < 4; ++j) { v[j] = xr[64 * j]; s += dot4(v[j]); }
            s = wave_sum(s);
            if (lane == 0) rstd_x[row] = rsqrtf(s * (1.0f / DM) + EPS);
            u32x2* o8 = (u32x2*)(Xb + (size_t)row * DM) + lane;
#pragma unroll
            for (int j = 0; j < 4; ++j) o8[64 * j] = pack4(v[j]);
        }
    }
    }
    grid.sync();
    for (int rep_ = 0; rep_ <= ((REPMASK >> 1) & 1); ++rep_) {
    {
        pg8::Gemm g{Xb, Win_t, T, N1, DM}; pg8::StaticOrder S; S.init(T, N1, G, bx);
        Epi1 E{rstd_x, rope, Ckv, Cq, Kpe, U, ssq_kv, ssq_q};
        pg8::gemm_phase<Epi1, pg8::StaticOrder, true, true>(lds, g, S, E);
    }
    }
    xcd_barrier(xbar);
    for (int rep_ = 0; rep_ <= ((REPMASK >> 2) & 1); ++rep_) {
    {
        for (int wi = gw; wi < 4 * (T / 32); wi += NGW) {
            const int gg = wi & 3, chunk = wi >> 2;
            if (gg == 0) pool_item<2>(U, Mix, chunk, 0, lane); else if (gg == 1) pool_item<4>(U, Mix, chunk, 1, lane);
            else if (gg == 2) pool_item<8>(U, Mix, chunk, 2, lane); else pool_item<16>(U, Mix, chunk, 3, lane);
        }
        { pg8::Gemm g{Cq, Wq_t, T, 768, QL}; pg8::StaticOrder S; S.init(T, 768, G, bx); Epi2 E{ssq_q, rope, Qb};
          pg8::gemm_phase<Epi2, pg8::StaticOrder, true, true>(lds, g, S, E); }
        { pg8::Gemm g{Ckv, Wk_t, T, 512, KVL}; pg8::StaticOrder S; S.init(T, 512, G, bx); Epi3a E{ssq_kv, Kn};
          pg8::gemm_phase<Epi3a, pg8::StaticOrder, true, true>(lds, g, S, E); }
        { pg8::Gemm g{Wv_t, Ckv, 512, T, KVL}; pg8::StaticOrder S; S.init(512, T, G, bx); Epi3b E{ssq_kv, Vt};
          pg8::gemm_phase<Epi3b, pg8::StaticOrder, true, true>(lds, g, S, E); }
    }
    }
    xcd_barrier(xbar);
    for (int rep_ = 0; rep_ <= ((REPMASK >> 3) & 1); ++rep_) {
    for (int p = vcu; p < 256; p += G) {
        const int bh = p >> 2, pi = p & 3, b = bh >> 2, h = bh & 3;
        attn_unit(lds, Qb, Kn, Kpe, Vt, Mix, b, h, 7 - pi, tid, wid, lane);
        attn_unit(lds, Qb, Kn, Kpe, Vt, Mix, b, h, pi, tid, wid, lane);
    }
    }
    xcd_barrier(xbar);
    for (int rep_ = 0; rep_ <= ((REPMASK >> 4) & 1); ++rep_) {
    {
        pg8::Gemm g{Mix, Wo_t, T, DM, DM}; pg8::StaticOrder S; S.init(T, DM, G, bx); Epi4 E{Xb, Hb, ssq_h};
        pg8::gemm_phase<Epi4, pg8::StaticOrder, true, true>(lds, g, S, E);
    }
    }
    xcd_barrier(xbar);
    for (int rep_ = 0; rep_ <= ((REPMASK >> 5) & 1); ++rep_) {
    {
        pg8::Gemm g{Hb, Wup_t, T, FF, DM}; pg8::StaticOrder S; S.init(T, FF, G, bx); Epi5 E{ssq_h, Act};
        pg8::gemm_phase<Epi5, pg8::StaticOrder, true, true>(lds, g, S, E);
    }
    }
    xcd_barrier(xbar);
    for (int rep_ = 0; rep_ <= ((REPMASK >> 6) & 1); ++rep_) {
    {
        pg8::Gemm g{Act, Wdn_t, T, DM, FF}; pg8::StaticOrder S; S.init(T, DM, G, bx); Epi6 E{Hb, H2b, ssq_o};
        pg8::gemm_phase<Epi6, pg8::StaticOrder, true, true>(lds, g, S, E);
    }
    }
    xcd_barrier(xbar);
    for (int rep_ = 0; rep_ <= ((REPMASK >> 7) & 1); ++rep_) {
#ifdef XSYNC
    for (int xs_ = 0; xs_ < XSYNC; ++xs_) xcd_barrier(xbar);
#endif
    for (int row = gw; row < T; row += NGW) {
        float s = ssq_o[row * 16 + (lane & 15)];
        s += __shfl_xor(s, 1); s += __shfl_xor(s, 2); s += __shfl_xor(s, 4); s += __shfl_xor(s, 8);
        const float rs = rsqrtf(s * (1.0f / DM) + EPS);
        f32x4* orow = (f32x4*)(out + (size_t)row * DM) + lane; const u32x2* hrow = (const u32x2*)(H2b + (size_t)row * DM) + lane; const f32x4* gr = (const f32x4*)g_fin + lane;
#pragma unroll
        for (int j = 0; j < 4; ++j) { const u32x2 r = hrow[64 * j];
            const f32x4 hv = {__uint_as_float(r[0] << 16), __uint_as_float(r[0] & 0xffff0000u), __uint_as_float(r[1] << 16), __uint_as_float(r[1] & 0xffff0000u)};
            orow[64 * j] = hv * rs * gr[64 * j]; }
    }
    }
}

extern "C" void kernel_launch(void* const* d_in, const int* in_sizes, int n_in, void* d_out, int out_size, void* d_ws, size_t ws_size, hipStream_t stream) {
    static int grid = 0;
    if (grid == 0) {
        if (n_in != 15 || in_sizes[0] != T * DM || out_size != T * DM || ws_size < WS_END) { fprintf(stderr, "kernel_launch: unexpected shapes (n_in %d, in0 %d, out %d, ws %zu); nothing launched\n", n_in, n_in > 0 ? in_sizes[0] : -1, out_size, ws_size); grid = -1; return; }
        int dev = 0, cus = 0, per_cu = 0;
        if (hipGetDevice(&dev) != hipSuccess || hipDeviceGetAttribute(&cus, hipDeviceAttributeMultiprocessorCount, dev) != hipSuccess) { grid = -1; return; }
        if (hipFuncSetAttribute((const void*)mk_fwd, hipFuncAttributeMaxDynamicSharedMemorySize, LDS_BYTES) != hipSuccess) { fprintf(stderr, "kernel_launch: hipFuncSetAttribute failed\n"); grid = -1; return; }
        if (hipOccupancyMaxActiveBlocksPerMultiprocessor(&per_cu, (const void*)mk_fwd, NTHR, LDS_BYTES) != hipSuccess || per_cu < 1) per_cu = 1;
        (void)hipGetLastError();
        grid = cus * per_cu;
    }
    if (grid < 0) return;
    if (hipMemsetAsync((char*)d_ws + WS_CTL, 0, CTL_BYTES, stream) != hipSuccess) { fprintf(stderr, "kernel_launch: memset of the barrier words failed\n"); return; }
    Args a{};
    for (int i = 0; i < 15; ++i) a.in[i] = (const float*)d_in[i];
    a.out = (float*)d_out; a.ws = (unsigned char*)d_ws;
    void* args[] = {&a};
    const hipError_t e = hipLaunchCooperativeKernel((const void*)mk_fwd, dim3(grid), dim3(NTHR), args, LDS_BYTES, stream);
    if (e != hipSuccess) fprintf(stderr, "kernel_launch: cooperative launch failed: %s (grid %d)\n", hipGetErrorString(e), grid);
}
```

```cpp
#include <hip/hip_runtime.h>
#include <hip/hip_cooperative_groups.h>
#include <cstdio>
#include <cstdint>
namespace cg = cooperative_groups;
namespace pg8 {
#define PG8_LAS __attribute__((address_space(3)))
typedef unsigned short bf16_t;
typedef short bf16x8 __attribute__((ext_vector_type(8)));
typedef float f32x4 __attribute__((ext_vector_type(4)));
typedef unsigned u32x4 __attribute__((ext_vector_type(4)));
constexpr int BM = 256, BK = 64, HALF = 128, HTB = HALF * BK * 2  , STAGE_BYTES = 8 * HTB, NXCD = 8, WGM = 8;

__host__ __device__ __forceinline__ int lds_byte(int r, int c) { const int st = (r >> 4) * 2 + (c >> 5), rr = r & 15, cc = c & 31, ob = rr * 64 + cc * 2; return st * 1024 + (ob ^ (((ob >> 9) & 1) << 5)); }
__host__ __device__ __forceinline__ void stage_rc(int b, int& R, int& C) { const int st = b / 1024, sb = b % 1024, swz = sb ^ (((sb >> 9) & 1) << 5); R = (st >> 1) * 16 + swz / 64; C = (st & 1) * 32 + (swz % 64) / 2; }
__host__ __device__ __forceinline__ int perm32(int rho) { const int n = rho >> 4, i = rho & 15; return 8 * (i >> 2) + 4 * n + (i & 3); }

struct Unit { int pm, pn; };
struct Gemm { const bf16_t* A; const bf16_t* Bt; int M, N, K; };

struct StaticOrder {
    int nM, nN, nwg, G, c;
    __host__ __device__ void init(int M, int N, int G_, int c_) { nM = M / BM; nN = N / BM; nwg = nM * nN; G = G_; c = c_; }
    __host__ __device__ bool next(int i, Unit& u) const {
        const long L = (long)i * G + c; if (L >= nwg) return false;
        int wgid = (int)L; { const int q = nwg / NXCD, r = nwg % NXCD, xcd = wgid % NXCD, off = wgid / NXCD; wgid = (xcd < r ? xcd * (q + 1) : r * (q + 1) + (xcd - r) * q) + off; }
        const int nig = WGM * nN, gid = wgid / nig, fm = gid * WGM, gsz = (nM - fm) < WGM ? (nM - fm) : WGM;
        u.pm = fm + ((wgid % nig) % gsz); u.pn = (wgid % nig) / gsz; return true;
    }
    __device__ __forceinline__ void a_ready(const Unit&) const {}
    __device__ __forceinline__ void done(const Unit&) const {}
};

__device__ __forceinline__ unsigned cvt_pk_bf16(float lo, float hi) { unsigned r; asm volatile("v_cvt_pk_bf16_f32 %0, %1, %2" : "=v"(r) : "v"(lo), "v"(hi)); return r; }
typedef float f32x2 __attribute__((ext_vector_type(2)));
template <class Epi, class Sched, bool ALIGN_EPI = false, bool SP2 = false>
__device__ __forceinline__ void gemm_phase(PG8_LAS unsigned char* lds, const Gemm g, const Sched& S, const Epi& E) {
    int tid_l = threadIdx.x; asm volatile("" : "+v"(tid_l));
    const int tid = tid_l, wid = __builtin_amdgcn_readfirstlane(tid >> 6), lane = tid & 63, wr = wid >> 2, wc = wid & 3, fr = lane & 15, fq = lane >> 4;
    const int K = g.K, nt = K / BK;
    unsigned voffA[2], voffB[2];
#pragma unroll
    for (int i = 0; i < 2; ++i) { int R, C; stage_rc(tid * 16 + i * 8192, R, C); const int Rb = Epi::PERM ? ((R & ~31) + perm32(R & 31)) : R;
        voffA[i] = (unsigned)(R * K + C) * 2u; voffB[i] = (unsigned)(Rb * K + C) * 2u; }
    const size_t kstep = (size_t)(BK * 2);
    const size_t hstep = (size_t)HALF * K * 2;
    const size_t tstep = 2 * hstep;
    const unsigned ldsw = (unsigned)wid * 1024u;
    const int aoff = lds_byte(wr * 64 + fr, fq * 8), boff = lds_byte(wc * 32 + fr, fq * 8);
#define PG8_SA(b, h) (((b) * 2 + (h)) * HTB)
#define PG8_SB(b, h) ((4 + (b) * 2 + (h)) * HTB)
#define PG8_STAGE(bufoff, gbase, voff) do { _Pragma("unroll") for (int _i = 0; _i < 2; ++_i) \
        __builtin_amdgcn_global_load_lds((const unsigned*)((const char*)(gbase) + (voff)[_i]), (PG8_LAS unsigned*)(lds + (bufoff) + ldsw + _i * 8192), 16, 0, 0); } while (0)
#define PG8_LDA(dst, b, h) do { _Pragma("unroll") for (int m = 0; m < 4; ++m) _Pragma("unroll") for (int k = 0; k < 2; ++k) dst[m][k] = *(const PG8_LAS bf16x8*)(lds + PG8_SA(b, h) + aoff + m * 2048 + k * 1024); } while (0)
#define PG8_LDB(dst, b, h) do { _Pragma("unroll") for (int n = 0; n < 2; ++n) _Pragma("unroll") for (int k = 0; k < 2; ++k) dst[n][k] = *(const PG8_LAS bf16x8*)(lds + PG8_SB(b, h) + boff + n * 2048 + k * 1024); } while (0)
#define PG8_MMA(ai, bj, At, Bt) do { __builtin_amdgcn_s_setprio(1); _Pragma("unroll") for (int m = 0; m < 4; ++m) _Pragma("unroll") for (int n = 0; n < 2; ++n) _Pragma("unroll") for (int k = 0; k < 2; ++k) \
        acc[ai][bj][m][n] = __builtin_amdgcn_mfma_f32_16x16x32_bf16(Bt[n][k], At[m][k], acc[ai][bj][m][n], 0, 0, 0); __builtin_amdgcn_s_setprio(0); } while (0)
#define PG8_WAIT_V(n) asm volatile("s_waitcnt vmcnt(" #n ")" ::: "memory")
#define PG8_WAIT_L(n) asm volatile("s_waitcnt lgkmcnt(" #n ")" ::: "memory")
#define PG8_BAR __builtin_amdgcn_s_barrier()
#define PG8_SCHED __builtin_amdgcn_sched_barrier(0)
    Unit cur, nxt; int ui = 0;
    if (!S.next(0, cur)) return;
    f32x4 acc[2][2][4][2];
#pragma unroll
    for (int a = 0; a < 2; ++a)
#pragma unroll
        for (int b = 0; b < 2; ++b)
#pragma unroll
            for (int m = 0; m < 4; ++m)
#pragma unroll
                for (int n = 0; n < 2; ++n) acc[a][b][m][n] = (f32x4){0.f, 0.f, 0.f, 0.f};
    bf16x8 At[4][2], B0[2][2], B1[2][2];
    const char* cA = (const char*)g.A + (size_t)cur.pm * tstep; const char* cB = (const char*)g.Bt + (size_t)cur.pn * tstep;
    S.a_ready(cur);
    if constexpr (SP2) {
        PG8_STAGE(PG8_SB(0, 0), cB, voffB); PG8_STAGE(PG8_SB(0, 1), cB + hstep, voffB); PG8_STAGE(PG8_SA(0, 0), cA, voffA); PG8_STAGE(PG8_SA(0, 1), cA + hstep, voffA);
        if (wr == 1) PG8_BAR;
        PG8_WAIT_V(2); PG8_BAR;
        PG8_STAGE(PG8_SB(1, 0), cB + kstep, voffB); PG8_STAGE(PG8_SA(1, 0), cA + kstep, voffA); PG8_STAGE(PG8_SB(1, 1), cB + hstep + kstep, voffB);
        PG8_WAIT_V(6); PG8_BAR;
    } else {
        PG8_STAGE(PG8_SB(0, 0), cB, voffB); PG8_STAGE(PG8_SA(0, 0), cA, voffA); PG8_STAGE(PG8_SB(0, 1), cB + hstep, voffB); PG8_STAGE(PG8_SA(0, 1), cA + hstep, voffA);
        if (wr == 1) PG8_BAR;
        PG8_WAIT_V(4); PG8_BAR;
        PG8_STAGE(PG8_SB(1, 0), cB + kstep, voffB); PG8_STAGE(PG8_SA(1, 0), cA + kstep, voffA); PG8_STAGE(PG8_SB(1, 1), cB + hstep + kstep, voffB);
        PG8_WAIT_V(6); PG8_BAR;
    }
    for (;;) {
        const bool has_next = S.next(ui + 1, nxt);
        const char* nA = has_next ? (const char*)g.A + (size_t)nxt.pm * tstep : cA; const char* nB = has_next ? (const char*)g.Bt + (size_t)nxt.pn * tstep : cB;
#pragma unroll 1
        for (int t = 0; t < nt; t += 2) {
            const bool last = (t == nt - 2);
            const char* a1 = cA + (size_t)(t + 1) * kstep;
            const char* a2 = last ? nA : cA + (size_t)(t + 2) * kstep; const char* b2 = last ? nB : cB + (size_t)(t + 2) * kstep;
            const char* a3 = a2 + kstep; const char* b3 = b2 + kstep;
            if (last && has_next) S.a_ready(nxt);
            if constexpr (SP2) {
            PG8_LDB(B0, 0, 0); PG8_LDB(B1, 0, 1); PG8_SCHED; PG8_LDA(At, 0, 0); PG8_STAGE(PG8_SA(1, 1), a1 + hstep, voffA);
            PG8_WAIT_V(8); PG8_WAIT_L(0); PG8_BAR; PG8_MMA(0, 0, At, B0); PG8_MMA(0, 1, At, B1); PG8_BAR; PG8_SCHED;
            PG8_LDA(At, 0, 1); PG8_STAGE(PG8_SB(0, 0), b2, voffB); PG8_STAGE(PG8_SB(0, 1), b2 + hstep, voffB); PG8_STAGE(PG8_SA(0, 0), a2, voffA);
            PG8_WAIT_V(8); PG8_WAIT_L(0); PG8_BAR; PG8_MMA(1, 0, At, B0); PG8_MMA(1, 1, At, B1); PG8_BAR; PG8_SCHED;
            PG8_LDB(B0, 1, 0); PG8_LDB(B1, 1, 1); PG8_SCHED; PG8_LDA(At, 1, 0); PG8_STAGE(PG8_SA(0, 1), a2 + hstep, voffA);
            PG8_WAIT_V(8); PG8_WAIT_L(0); PG8_BAR; PG8_MMA(0, 0, At, B0); PG8_MMA(0, 1, At, B1); PG8_BAR; PG8_SCHED;
            PG8_LDA(At, 1, 1); PG8_STAGE(PG8_SB(1, 0), b3, voffB); PG8_STAGE(PG8_SB(1, 1), b3 + hstep, voffB); PG8_STAGE(PG8_SA(1, 0), a3, voffA);
            PG8_WAIT_V(8); PG8_WAIT_L(0); PG8_BAR; PG8_MMA(1, 0, At, B0); PG8_MMA(1, 1, At, B1); PG8_BAR; PG8_SCHED;
            } else {
            PG8_LDB(B0, 0, 0); PG8_SCHED; PG8_LDA(At, 0, 0); PG8_STAGE(PG8_SA(1, 1), a1 + hstep, voffA);
            PG8_WAIT_L(8); PG8_BAR; PG8_WAIT_L(0); PG8_MMA(0, 0, At, B0); PG8_BAR; PG8_SCHED;
            PG8_LDB(B1, 0, 1); PG8_STAGE(PG8_SB(0, 0), b2, voffB);
            PG8_BAR; PG8_WAIT_L(0); PG8_MMA(0, 1, At, B1); PG8_BAR;
            PG8_LDA(At, 0, 1); PG8_STAGE(PG8_SA(0, 0), a2, voffA);
            PG8_BAR; PG8_WAIT_L(0); PG8_MMA(1, 0, At, B0); PG8_BAR; PG8_SCHED;
            PG8_STAGE(PG8_SB(0, 1), b2 + hstep, voffB);
            PG8_WAIT_V(6); PG8_BAR; PG8_MMA(1, 1, At, B1); PG8_BAR;
            PG8_LDB(B0, 1, 0); PG8_SCHED; PG8_LDA(At, 1, 0); PG8_STAGE(PG8_SA(0, 1), a2 + hstep, voffA);
            PG8_WAIT_L(8); PG8_BAR; PG8_WAIT_L(0); PG8_MMA(0, 0, At, B0); PG8_BAR; PG8_SCHED;
            PG8_LDB(B1, 1, 1); PG8_STAGE(PG8_SB(1, 0), b3, voffB);
            PG8_BAR; PG8_WAIT_L(0); PG8_MMA(0, 1, At, B1); PG8_BAR;
            PG8_LDA(At, 1, 1); PG8_STAGE(PG8_SA(1, 0), a3, voffA);
            PG8_BAR; PG8_WAIT_L(0); PG8_MMA(1, 0, At, B0); PG8_BAR; PG8_SCHED;
            PG8_STAGE(PG8_SB(1, 1), b3 + hstep, voffB);
            PG8_WAIT_V(6); PG8_BAR; PG8_MMA(1, 1, At, B1); PG8_BAR;
            }
        }
        if constexpr (ALIGN_EPI) { if (wr == 0) PG8_BAR; }
        if constexpr (!Epi::AFTER_DRAIN) { E(acc, cur, wr, wc, fr, fq); S.done(cur); }
        if (!has_next) break;
#pragma unroll
        for (int a = 0; a < 2; ++a)
#pragma unroll
            for (int b = 0; b < 2; ++b)
#pragma unroll
                for (int m = 0; m < 4; ++m)
#pragma unroll
                    for (int n = 0; n < 2; ++n) acc[a][b][m][n] = (f32x4){0.f, 0.f, 0.f, 0.f};
        cur = nxt; cA = nA; cB = nB; ++ui;
        if constexpr (ALIGN_EPI) { if (wr == 1) PG8_BAR; }
    }
    PG8_WAIT_V(0);
    if constexpr (!ALIGN_EPI) { if (wr == 0) PG8_BAR; }
    PG8_BAR;
    if constexpr (Epi::AFTER_DRAIN) { E.fused(acc, cur, wr, wc, fr, fq, lds, wid, lane); S.done(cur); }
#undef PG8_SA
#undef PG8_SB
#undef PG8_STAGE
#undef PG8_LDA
#undef PG8_LDB
#undef PG8_MMA
#undef PG8_WAIT_V
#undef PG8_WAIT_L
#undef PG8_BAR
#undef PG8_SCHED
}
}

#define LAS __attribute__((address_space(3)))
using pg8::bf16_t; using pg8::bf16x8; using pg8::f32x4; using pg8::u32x4; using pg8::Unit; using pg8::cvt_pk_bf16;
typedef unsigned u32x2 __attribute__((ext_vector_type(2)));
typedef short s16x4 __attribute__((ext_vector_type(4)));
constexpr int T = 32768, SEQ = 2048, DM = 1024, NH = 4, QL = 384, KVL = 256, PW = 512, INW = 1216, FF = 4096;
constexpr int N1 = 1280;
constexpr float EPS = 1e-6f;
constexpr float QSCALE = 0.07216878364870322f * 1.4426950408889634f;
constexpr int NTHR = 512, NWAVES = 8;
constexpr int LDS_BYTES = 147456;

constexpr size_t MiB = 1u << 20;
constexpr size_t WS_WIN = 0, WS_WQ = 3 * MiB, WS_WK = 4 * MiB, WS_WV = 4 * MiB + 512 * 1024, WS_WO = 5 * MiB, WS_WUP = 7 * MiB, WS_WDN = 15 * MiB;
constexpr size_t WS_ROPE = 23 * MiB, WS_RSTDX = 31 * MiB, WS_SSQKV = 31 * MiB + 256 * 1024, WS_SSQQ = 32 * MiB, WS_SSQH = 33 * MiB, WS_SSQO = 35 * MiB;
constexpr size_t WS_HB = 40 * MiB, WS_XB = 104 * MiB, WS_CQ = 168 * MiB, WS_CKV = 192 * MiB, WS_KPE = 208 * MiB, WS_U = 212 * MiB, WS_Q = 244 * MiB, WS_KN = 292 * MiB,
                 WS_VT = 324 * MiB, WS_MIX = 356 * MiB, WS_ACT = 104 * MiB, WS_H2 = 360 * MiB, WS_END = 424 * MiB;
constexpr size_t WS_CTL = 38 * MiB, CTL_BYTES = 16384;

__device__ __forceinline__ float bf2f(unsigned short h) { return __uint_as_float((unsigned)h << 16); }
__device__ __forceinline__ u32x4 pack8(const f32x4 a, const f32x4 b) { u32x4 w; w.x = cvt_pk_bf16(a[0], a[1]); w.y = cvt_pk_bf16(a[2], a[3]); w.z = cvt_pk_bf16(b[0], b[1]); w.w = cvt_pk_bf16(b[2], b[3]); return w; }
__device__ __forceinline__ u32x2 pack4(const f32x4 a) { u32x2 w; w.x = cvt_pk_bf16(a[0], a[1]); w.y = cvt_pk_bf16(a[2], a[3]); return w; }
__device__ __forceinline__ float wave_sum(float v) {
#pragma unroll
    for (int o = 1; o < 64; o <<= 1) v += __shfl_xor(v, o);
    return v;
}
__device__ __forceinline__ float quad_fq_sum(float s) { s += __shfl_xor(s, 16); s += __shfl_xor(s, 32); return s; }
__device__ __forceinline__ float dot4(const f32x4 a) { return (a[0] * a[0] + a[1] * a[1]) + (a[2] * a[2] + a[3] * a[3]); }

__device__ __forceinline__ int ropeperm(int y) { const int w = y >> 5, rem = y & 31, fq = rem >> 3, n = (rem >> 2) & 1, j = rem & 3; return 16 * w + 4 * fq + j + 32 * n; }
__device__ __forceinline__ int cm_win(int g) { if (g < 256) return 384 + g; if (g < 512) return g - 256; if (g < 640) return 256 + (g - 512); if (g < 704) return 640 + ropeperm(g - 640); if (g < 768) return -1; return 704 + (g - 768); }
__device__ __forceinline__ int cm_wq(int g) { if (g < 512) return (g >> 7) * 192 + (g & 127); const int x = g - 512; return (x >> 6) * 192 + 128 + ropeperm(x & 63); }
__device__ __forceinline__ int cm_wk(int g) { return (g >> 7) * 256 + (g & 127); }
__device__ __forceinline__ int cm_wv(int g) { return (g >> 7) * 256 + 128 + (g & 127); }

__device__ __forceinline__ void rope4(const f32x4 x1, const f32x4 x2, const float* cs, f32x4& lo, f32x4& hi) {
    const f32x4 t0 = *(const f32x4*)cs, t1 = *(const f32x4*)(cs + 4);
    const f32x4 c = {t0[0], t0[2], t1[0], t1[2]}, s = {t0[1], t0[3], t1[1], t1[3]};
    lo = x1 * c - x2 * s; hi = x2 * c + x1 * s;
}

struct Epi1 {
    static constexpr bool PERM = true, AFTER_DRAIN = false;
    const float* rstd_x; const float* rope; bf16_t* Ckv; bf16_t* Cq; bf16_t* Kpe; bf16_t* U; float* ssq_kv; float* ssq_q;
    __device__ __forceinline__ void operator()(const f32x4 (&acc)[2][2][4][2], const Unit& u, int wr, int wc, int fr, int fq) const {
        const int pn = u.pn, c8 = wc * 32 + 8 * fq;
#pragma unroll
        for (int ai = 0; ai < 2; ++ai)
#pragma unroll
            for (int m = 0; m < 4; ++m) {
                const int row = u.pm * 256 + ai * 128 + wr * 64 + m * 16 + fr;
                const float rs = rstd_x[row];
                f32x4 v[2][2];
#pragma unroll
                for (int bj = 0; bj < 2; ++bj)
#pragma unroll
                    for (int n = 0; n < 2; ++n) v[bj][n] = acc[ai][bj][m][n] * rs;
                if (pn == 0) {
                    *(u32x4*)(Ckv + (size_t)row * KVL + c8) = pack8(v[0][0], v[0][1]); *(u32x4*)(Ckv + (size_t)row * KVL + 128 + c8) = pack8(v[1][0], v[1][1]);
                    const float s = quad_fq_sum((dot4(v[0][0]) + dot4(v[0][1])) + (dot4(v[1][0]) + dot4(v[1][1])));
                    if (fq == 0) ssq_kv[row * 4 + wc] = s;
                } else if (pn == 1) {
                    *(u32x4*)(Cq + (size_t)row * QL + c8) = pack8(v[0][0], v[0][1]); *(u32x4*)(Cq + (size_t)row * QL + 128 + c8) = pack8(v[1][0], v[1][1]);
                    const float s = quad_fq_sum((dot4(v[0][0]) + dot4(v[0][1])) + (dot4(v[1][0]) + dot4(v[1][1])));
                    if (fq == 0) ssq_q[row * 8 + wc] = s;
                } else if (pn == 2) {
                    *(u32x4*)(Cq + (size_t)row * QL + 256 + c8) = pack8(v[0][0], v[0][1]);
                    const float s = quad_fq_sum(dot4(v[0][0]) + dot4(v[0][1]));
                    if (fq == 0) ssq_q[row * 8 + 4 + wc] = s;
                    if (wc < 2) { const int i0 = 16 * wc + 4 * fq; f32x4 lo, hi; rope4(v[1][0], v[1][1], rope + (size_t)row * 64 + 2 * i0, lo, hi);
                        *(u32x2*)(Kpe + (size_t)row * 64 + i0) = pack4(lo); *(u32x2*)(Kpe + (size_t)row * 64 + 32 + i0) = pack4(hi); }
                } else {
                    bf16_t* d = U + (size_t)row * PW + (pn - 3) * 256 + c8;
                    *(u32x4*)d = pack8(v[0][0], v[0][1]); *(u32x4*)(d + 128) = pack8(v[1][0], v[1][1]);
                }
                asm volatile("" ::: "memory");
            }
    }
};
struct Epi2 {
    static constexpr bool PERM = true, AFTER_DRAIN = false;
    const float* ssq_q; const float* rope; bf16_t* Q;
    __device__ __forceinline__ void operator()(const f32x4 (&acc)[2][2][4][2], const Unit& u, int wr, int wc, int fr, int fq) const {
        const int pn = u.pn, c8 = wc * 32 + 8 * fq;
#pragma unroll
        for (int ai = 0; ai < 2; ++ai)
#pragma unroll
            for (int m = 0; m < 4; ++m) {
                const int row = u.pm * 256 + ai * 128 + wr * 64 + m * 16 + fr;
                const f32x4 p0 = *(const f32x4*)(ssq_q + row * 8), p1 = *(const f32x4*)(ssq_q + row * 8 + 4);
                const float rs = rsqrtf(((p0[0] + p0[1]) + (p0[2] + p0[3]) + (p1[0] + p1[1]) + (p1[2] + p1[3])) * (1.0f / QL) + EPS) * QSCALE;
                bf16_t* qrow = Q + (size_t)row * 768;
#pragma unroll
                for (int bj = 0; bj < 2; ++bj) {
                    const f32x4 v0 = acc[ai][bj][m][0] * rs, v1 = acc[ai][bj][m][1] * rs;
                    if (pn < 2) { *(u32x4*)(qrow + (pn * 2 + bj) * 192 + c8) = pack8(v0, v1); }
                    else { const int head = 2 * bj + (wc >> 1), i0 = 16 * (wc & 1) + 4 * fq; f32x4 lo, hi; rope4(v0, v1, rope + (size_t)row * 64 + 2 * i0, lo, hi);
                        *(u32x2*)(qrow + head * 192 + 128 + i0) = pack4(lo); *(u32x2*)(qrow + head * 192 + 160 + i0) = pack4(hi); }
                }
                asm volatile("" ::: "memory");
            }
    }
};
struct Epi3a {
    static constexpr bool PERM = true, AFTER_DRAIN = false;
    const float* ssq_kv; bf16_t* Kn;
    __device__ __forceinline__ void operator()(const f32x4 (&acc)[2][2][4][2], const Unit& u, int wr, int wc, int fr, int fq) const {
        const int c8 = u.pn * 256 + wc * 32 + 8 * fq;
#pragma unroll
        for (int ai = 0; ai < 2; ++ai)
#pragma unroll
            for (int m = 0; m < 4; ++m) {
                const int row = u.pm * 256 + ai * 128 + wr * 64 + m * 16 + fr;
                const f32x4 p0 = *(const f32x4*)(ssq_kv + row * 4);
                const float rs = rsqrtf(((p0[0] + p0[1]) + (p0[2] + p0[3])) * (1.0f / KVL) + EPS);
#pragma unroll
                for (int bj = 0; bj < 2; ++bj) *(u32x4*)(Kn + (size_t)row * 512 + bj * 128 + c8) = pack8(acc[ai][bj][m][0] * rs, acc[ai][bj][m][1] * rs);
                asm volatile("" ::: "memory");
            }
    }
};
struct Epi3b {
    static constexpr bool PERM = true, AFTER_DRAIN = false;
    const float* ssq_kv; bf16_t* Vt;
    __device__ __forceinline__ void operator()(const f32x4 (&acc)[2][2][4][2], const Unit& u, int wr, int wc, int fr, int fq) const {
        const int t8 = u.pn * 256 + wc * 32 + 8 * fq;
#pragma unroll
        for (int bj = 0; bj < 2; ++bj) {
            f32x4 rs[2];
#pragma unroll
            for (int e = 0; e < 8; ++e) { const f32x4 p0 = *(const f32x4*)(ssq_kv + (size_t)(t8 + bj * 128 + e) * 4);
                rs[e >> 2][e & 3] = rsqrtf(((p0[0] + p0[1]) + (p0[2] + p0[3])) * (1.0f / KVL) + EPS); }
#pragma unroll
            for (int ai = 0; ai < 2; ++ai)
#pragma unroll
                for (int m = 0; m < 4; ++m) {
                    const int hv = u.pm * 256 + ai * 128 + wr * 64 + m * 16 + fr;
                    *(u32x4*)(Vt + (size_t)hv * T + bj * 128 + t8) = pack8(acc[ai][bj][m][0] * rs[0], acc[ai][bj][m][1] * rs[1]);
                }
            asm volatile("" ::: "memory");
        }
    }
};
__device__ __forceinline__ void unpack8(const u32x4 r, f32x4& a, f32x4& b) {
    a = (f32x4){__uint_as_float(r[0] << 16), __uint_as_float(r[0] & 0xffff0000u), __uint_as_float(r[1] << 16), __uint_as_float(r[1] & 0xffff0000u)};
    b = (f32x4){__uint_as_float(r[2] << 16), __uint_as_float(r[2] & 0xffff0000u), __uint_as_float(r[3] << 16), __uint_as_float(r[3] & 0xffff0000u)};
}
struct Epi4 {
    static constexpr bool PERM = true, AFTER_DRAIN = false;
    const bf16_t* Xb; bf16_t* Hb; float* ssq_h;
    __device__ __forceinline__ void operator()(const f32x4 (&acc)[2][2][4][2], const Unit& u, int wr, int wc, int fr, int fq) const {
        const int c8 = u.pn * 256 + wc * 32 + 8 * fq;
#pragma unroll
        for (int ai = 0; ai < 2; ++ai)
#pragma unroll
            for (int m = 0; m < 4; ++m) {
                const int row = u.pm * 256 + ai * 128 + wr * 64 + m * 16 + fr;
                float s = 0.f;
#pragma unroll
                for (int bj = 0; bj < 2; ++bj) { const size_t off = (size_t)row * DM + bj * 128 + c8;
                    f32x4 x0, x1; unpack8(*(const u32x4*)(Xb + off), x0, x1);
                    const f32x4 h0 = x0 + acc[ai][bj][m][0], h1 = x1 + acc[ai][bj][m][1];
                    *(u32x4*)(Hb + off) = pack8(h0, h1); s += dot4(h0) + dot4(h1); }
                s = quad_fq_sum(s);
                if (fq == 0) ssq_h[row * 16 + u.pn * 4 + wc] = s;
                asm volatile("" ::: "memory");
            }
    }
};
struct Epi5 {
    static constexpr bool PERM = true, AFTER_DRAIN = false;
    const float* ssq_h; bf16_t* Act;
    __device__ __forceinline__ void operator()(const f32x4 (&acc)[2][2][4][2], const Unit& u, int wr, int wc, int fr, int fq) const {
        const int c8 = u.pn * 256 + wc * 32 + 8 * fq;
#pragma unroll
        for (int ai = 0; ai < 2; ++ai)
#pragma unroll
            for (int m = 0; m < 4; ++m) {
                const int row = u.pm * 256 + ai * 128 + wr * 64 + m * 16 + fr;
                const f32x4 p0 = *(const f32x4*)(ssq_h + row * 16), p1 = *(const f32x4*)(ssq_h + row * 16 + 4), p2 = *(const f32x4*)(ssq_h + row * 16 + 8), p3 = *(const f32x4*)(ssq_h + row * 16 + 12);
                const f32x4 ps = (p0 + p1) + (p2 + p3);
                const float rs = rsqrtf(((ps[0] + ps[1]) + (ps[2] + ps[3])) * (1.0f / DM) + EPS);
#pragma unroll
                for (int bj = 0; bj < 2; ++bj) { f32x4 v0 = acc[ai][bj][m][0] * rs, v1 = acc[ai][bj][m][1] * rs;
#pragma unroll
                    for (int e = 0; e < 4; ++e) { const float a = fmaxf(v0[e], 0.f), b = fmaxf(v1[e], 0.f); v0[e] = a * a; v1[e] = b * b; }
                    *(u32x4*)(Act + (size_t)row * FF + bj * 128 + c8) = pack8(v0, v1); }
                asm volatile("" ::: "memory");
            }
    }
};
struct Epi6 {
    static constexpr bool PERM = true, AFTER_DRAIN = false;
    const bf16_t* Hb; bf16_t* H2b; float* ssq_o;
    __device__ __forceinline__ void operator()(const f32x4 (&acc)[2][2][4][2], const Unit& u, int wr, int wc, int fr, int fq) const {
        const int c8 = u.pn * 256 + wc * 32 + 8 * fq;
#pragma unroll
        for (int ai = 0; ai < 2; ++ai)
#pragma unroll
            for (int m = 0; m < 4; ++m) {
                const int row = u.pm * 256 + ai * 128 + wr * 64 + m * 16 + fr;
                float s = 0.f;
#pragma unroll
                for (int bj = 0; bj < 2; ++bj) { const size_t off = (size_t)row * DM + bj * 128 + c8;
                    f32x4 x0, x1; unpack8(*(const u32x4*)(Hb + off), x0, x1);
                    const f32x4 h0 = x0 + acc[ai][bj][m][0], h1 = x1 + acc[ai][bj][m][1];
                    *(u32x4*)(H2b + off) = pack8(h0, h1); s += dot4(h0) + dot4(h1); }
                s = quad_fq_sum(s);
                if (fq == 0) ssq_o[row * 16 + u.pn * 4 + wc] = s;
                asm volatile("" ::: "memory");
            }
    }
};

#define LDS_WAIT() asm volatile("s_waitcnt lgkmcnt(0)" ::: "memory")
template <int MAT>
__device__ __forceinline__ void tr_item(const float* __restrict__ W, int ldw, const float* __restrict__ gain, bf16_t* __restrict__ WT, int ldd, int nblk, LAS float* scr, int item, int lane) {
    const int kb = item / nblk, nb = item % nblk, k0 = 64 * kb, n0 = 32 * nb, gcol = n0 + (lane & 31);
    const int sc = MAT == 0 ? cm_win(gcol) : MAT == 1 ? cm_wq(gcol) : MAT == 2 ? cm_wk(gcol) : MAT == 3 ? cm_wv(gcol) : gcol;
#pragma unroll 8
    for (int i = 0; i < 32; ++i) { const int kk = 2 * i + (lane >> 5); float v = 0.f;
        if (sc >= 0) { v = W[(size_t)(k0 + kk) * ldw + sc]; if (gain) v *= gain[k0 + kk]; }
        scr[kk * 33 + (lane & 31)] = v; }
    LDS_WAIT(); asm volatile("" ::: "memory");
    const int c = lane & 7;
#pragma unroll
    for (int j = 0; j < 4; ++j) { const int n = (lane >> 3) + 8 * j; const LAS float* s = scr + (8 * c) * 33 + n;
        u32x4 o; o.x = cvt_pk_bf16(s[0 * 33], s[1 * 33]); o.y = cvt_pk_bf16(s[2 * 33], s[3 * 33]); o.z = cvt_pk_bf16(s[4 * 33], s[5 * 33]); o.w = cvt_pk_bf16(s[6 * 33], s[7 * 33]);
        *(u32x4*)(WT + (size_t)(n0 + n) * ldd + k0 + 8 * c) = o; }
    LDS_WAIT(); asm volatile("" ::: "memory");
}

template <int W>
__device__ __forceinline__ void pool_item(const bf16_t* __restrict__ U, bf16_t* __restrict__ Mix, int chunk, int gg, int lane) {
    const int sub = lane >> 4, c = lane & 15, r0 = chunk * 32 + sub * 8, s0 = r0 & (SEQ - 1);
    const bf16_t* up = U + (size_t)r0 * PW + gg * 128 + c * 8;
    u32x4 raw[W + 7];
#pragma unroll
    for (int j = 0; j < W + 7; ++j) { const int dj = j - (W - 1); raw[j] = (s0 + dj >= 0) ? *(const u32x4*)(up + (long)dj * PW) : (u32x4){0u, 0u, 0u, 0u}; }
    float S[8];
#pragma unroll
    for (int e = 0; e < 8; ++e) S[e] = 0.f;
#pragma unroll
    for (int j = 0; j < W; ++j)
#pragma unroll
        for (int e = 0; e < 4; ++e) { S[2 * e] += __uint_as_float(raw[j][e] << 16); S[2 * e + 1] += __uint_as_float(raw[j][e] & 0xffff0000u); }
    bf16_t* op = Mix + (size_t)r0 * DM + 512 + gg * 128 + c * 8;
#pragma unroll
    for (int i = 0; i < 8; ++i) {
        const int cnt = (s0 + i + 1 < W) ? s0 + i + 1 : W; const float ic = 1.0f / (float)cnt;
        const u32x4 cur = raw[i + W - 1]; u32x4 o;
#pragma unroll
        for (int e = 0; e < 4; ++e) o[e] = cvt_pk_bf16(S[2 * e] * ic - __uint_as_float(cur[e] << 16), S[2 * e + 1] * ic - __uint_as_float(cur[e] & 0xffff0000u));
        *(u32x4*)(op + (size_t)i * DM) = o;
        if (i < 7) {
#pragma unroll
            for (int e = 0; e < 4; ++e) { S[2 * e] += __uint_as_float(raw[i + W][e] << 16) - __uint_as_float(raw[i][e] << 16); S[2 * e + 1] += __uint_as_float(raw[i + W][e] & 0xffff0000u) - __uint_as_float(raw[i][e] & 0xffff0000u); }
        }
    }
}

constexpr int KN_B = 64 * 256, KR_B = 64 * 128, VT_B = 128 * 128, STG_B = KN_B + KR_B + VT_B;
static_assert(2 * STG_B <= 131072, "attention LDS");

__device__ __forceinline__ void attn_unit(LAS unsigned char* lds, const bf16_t* __restrict__ Q, const bf16_t* __restrict__ Kn, const bf16_t* __restrict__ Kpe,
                                          const bf16_t* __restrict__ Vt, bf16_t* __restrict__ Mix, int b, int h, int qb, int tid, int wid, int lane_in) {
    int lane = lane_in; asm volatile("" : "+v"(lane));
    const int fr = lane & 15, g = lane >> 4;
    const int q0 = qb * 256 + wid * 32;
    const size_t rb = (size_t)b * SEQ;
    bf16x8 qf[2][6];
#pragma unroll
    for (int q2 = 0; q2 < 2; ++q2)
#pragma unroll
        for (int ks = 0; ks < 6; ++ks) qf[q2][ks] = *(const bf16x8*)(Q + (rb + q0 + 16 * q2 + fr) * 768 + h * 192 + 32 * ks + 8 * g);
    f32x4 o[8][2];
#pragma unroll
    for (int vb = 0; vb < 8; ++vb) { o[vb][0] = (f32x4){0.f, 0.f, 0.f, 0.f}; o[vb][1] = (f32x4){0.f, 0.f, 0.f, 0.f}; }
    float mrun[2] = {-INFINITY, -INFINITY}, lrun[2] = {0.f, 0.f};
    const int nt = 4 * (qb + 1);
    unsigned oN[2], oV[2], oR;
#pragma unroll
    for (int r = 0; r < 2; ++r) { const int L = (r * 8 + wid) * 64 + lane;
        { const int key = L >> 4, pc = L & 15, cc = pc ^ (key & 15); oN[r] = (unsigned)(key * 1024 + cc * 16); }
        { const int vd = L >> 3, pc = L & 7, cc = pc ^ ((vd >> 1) & 7); oV[r] = (unsigned)(vd * (T * 2) + cc * 16); } }
    { const int L = wid * 64 + lane, key = L >> 3, pc = L & 7, cc = pc ^ ((key >> 1) & 7); oR = (unsigned)(key * 128 + cc * 16); }
    const char* bN = (const char*)(Kn + rb * 512 + h * 128); const char* bR = (const char*)(Kpe + rb * 64); const char* bV = (const char*)(Vt + (size_t)(h * 128) * T + rb);
#define ATT_DMA(kt, buf) do { LAS unsigned char* _d = lds + (buf) * STG_B; const char* _n = bN + (size_t)(kt) * (64 * 512 * 2); const char* _r = bR + (size_t)(kt) * (64 * 64 * 2); const char* _v = bV + (size_t)(kt) * 128; \
        __builtin_amdgcn_global_load_lds((const unsigned*)(_n + oN[0]), (LAS unsigned*)(_d + wid * 1024), 16, 0, 0); \
        __builtin_amdgcn_global_load_lds((const unsigned*)(_n + oN[1]), (LAS unsigned*)(_d + 8192 + wid * 1024), 16, 0, 0); \
        __builtin_amdgcn_global_load_lds((const unsigned*)(_r + oR), (LAS unsigned*)(_d + KN_B + wid * 1024), 16, 0, 0); \
        __builtin_amdgcn_global_load_lds((const unsigned*)(_v + oV[0]), (LAS unsigned*)(_d + KN_B + KR_B + wid * 1024), 16, 0, 0); \
        __builtin_amdgcn_global_load_lds((const unsigned*)(_v + oV[1]), (LAS unsigned*)(_d + KN_B + KR_B + 8192 + wid * 1024), 16, 0, 0); } while (0)
    const int swr = (fr >> 1) & 7;
    const int aN = fr * 256 + ((g ^ fr) << 4);
    const int aR = KN_B + fr * 128 + ((g ^ swr) << 4);
    const int aV = KN_B + KR_B + fr * 128 + (((g >> 1) ^ swr) << 4) + (g & 1) * 8;
    ATT_DMA(0, 0);
    asm volatile("s_waitcnt vmcnt(0)" ::: "memory");
    __syncthreads();
    for (int kt = 0; kt < nt; ++kt) {
        const int buf = kt & 1;
        if (kt + 1 < nt) ATT_DMA(kt + 1, buf ^ 1);
        if (kt * 64 <= q0 + 31) {
            LAS unsigned char* Sb = lds + buf * STG_B;
            f32x4 s[4][2];
#pragma unroll
            for (int kb = 0; kb < 4; ++kb) { s[kb][0] = (f32x4){0.f, 0.f, 0.f, 0.f}; s[kb][1] = (f32x4){0.f, 0.f, 0.f, 0.f}; }
#pragma unroll
            for (int ks = 0; ks < 6; ++ks) {
                bf16x8 kf[4];
#pragma unroll
                for (int kb = 0; kb < 4; ++kb) kf[kb] = (ks < 4) ? *(const LAS bf16x8*)(Sb + (aN ^ (ks * 64)) + kb * 4096) : *(const LAS bf16x8*)(Sb + (aR ^ ((ks - 4) * 64)) + kb * 2048);
#pragma unroll
                for (int kb = 0; kb < 4; ++kb) {
                    s[kb][0] = __builtin_amdgcn_mfma_f32_16x16x32_bf16(kf[kb], qf[0][ks], s[kb][0], 0, 0, 0);
                    s[kb][1] = __builtin_amdgcn_mfma_f32_16x16x32_bf16(kf[kb], qf[1][ks], s[kb][1], 0, 0, 0); }
            }
            if (kt * 64 + 63 > q0) {
#pragma unroll
                for (int q2 = 0; q2 < 2; ++q2) { const int qi = q0 + 16 * q2 + fr;
#pragma unroll
                    for (int kb = 0; kb < 4; ++kb)
#pragma unroll
                        for (int i = 0; i < 4; ++i) if (kt * 64 + 16 * kb + 4 * g + i > qi) s[kb][q2][i] = -INFINITY; }
            }
            bf16x8 pb[2][2];
#pragma unroll
            for (int q2 = 0; q2 < 2; ++q2) {
                float mx = fmaxf(fmaxf(s[0][q2][0], s[0][q2][1]), fmaxf(s[0][q2][2], s[0][q2][3]));
#pragma unroll
                for (int kb = 1; kb < 4; ++kb) mx = fmaxf(mx, fmaxf(fmaxf(s[kb][q2][0], s[kb][q2][1]), fmaxf(s[kb][q2][2], s[kb][q2][3])));
                mx = fmaxf(mx, __shfl_xor(mx, 16)); mx = fmaxf(mx, __shfl_xor(mx, 32));
                const float mnew = fmaxf(mrun[q2], mx), alpha = __builtin_amdgcn_exp2f(mrun[q2] - mnew);
                mrun[q2] = mnew;
                float rsum = 0.f;
#pragma unroll
                for (int kb = 0; kb < 4; ++kb)
#pragma unroll
                    for (int i = 0; i < 4; ++i) { const float p = __builtin_amdgcn_exp2f(s[kb][q2][i] - mnew); s[kb][q2][i] = p; rsum += p; }
                lrun[q2] = lrun[q2] * alpha + rsum;
#pragma unroll
                for (int vb = 0; vb < 8; ++vb) o[vb][q2] = o[vb][q2] * alpha;
#pragma unroll
                for (int k2 = 0; k2 < 2; ++k2) { const u32x4 w = pack8(s[2 * k2][q2], s[2 * k2 + 1][q2]); pb[q2][k2] = __builtin_bit_cast(bf16x8, w); }
            }
#pragma unroll
            for (int k2 = 0; k2 < 2; ++k2)
#pragma unroll
                for (int vq = 0; vq < 2; ++vq) {
                    bf16x8 vf[4];
#pragma unroll
                    for (int v4 = 0; v4 < 4; ++v4) { const LAS unsigned char* vp = Sb + (aV ^ (k2 * 64)) + (4 * vq + v4) * 2048; const LAS unsigned char* vph = Sb + (aV ^ (k2 * 64) ^ 32) + (4 * vq + v4) * 2048;
                        const s16x4 lo = *(const LAS s16x4*)vp, hi = *(const LAS s16x4*)vph;
                        vf[v4] = (bf16x8){lo[0], lo[1], lo[2], lo[3], hi[0], hi[1], hi[2], hi[3]}; }
#pragma unroll
                    for (int v4 = 0; v4 < 4; ++v4) {
                        o[4 * vq + v4][0] = __builtin_amdgcn_mfma_f32_16x16x32_bf16(vf[v4], pb[0][k2], o[4 * vq + v4][0], 0, 0, 0);
                        o[4 * vq + v4][1] = __builtin_amdgcn_mfma_f32_16x16x32_bf16(vf[v4], pb[1][k2], o[4 * vq + v4][1], 0, 0, 0); }
                }
        }
        asm volatile("s_waitcnt vmcnt(0)" ::: "memory");
        __syncthreads();
    }
#undef ATT_DMA
#pragma unroll
    for (int q2 = 0; q2 < 2; ++q2) {
        const float l = quad_fq_sum(lrun[q2]), inv = 1.0f / l;
        bf16_t* orow = Mix + (rb + q0 + 16 * q2 + fr) * DM + h * 128 + 4 * g;
#pragma unroll
        for (int vb = 0; vb < 8; ++vb) *(u32x2*)(orow + 16 * vb) = pack4(o[vb][q2] * inv);
    }
}

#define XB_TMO      128
#define XB_XCNT(j)  (256  + 64 * (j))
#define XB_XSUB(j)  (1280 + 64 * (j))
#define XB_XGEN(j)  (2304 + 64 * (j))
#define XB_TOP      3328
#define XB_TOPGEN   3392
#define XCD_BAR_WORDS 3456
#define XB_SPIN_CAP (1u << 18)

__device__ __forceinline__ unsigned xb_ld(unsigned* p)              { return __hip_atomic_load(p, __ATOMIC_RELAXED, __HIP_MEMORY_SCOPE_AGENT); }
__device__ __forceinline__ unsigned xb_add(unsigned* p, unsigned v) { return __hip_atomic_fetch_add(p, v, __ATOMIC_RELAXED, __HIP_MEMORY_SCOPE_AGENT); }
__device__ __forceinline__ unsigned xb_xcc_id() { return (unsigned)__builtin_amdgcn_s_getreg((3 << 11) | 20) & 0xFu; }
#define XB_SPIN(cond, bar) do { unsigned _sp = 0; while (cond) { __builtin_amdgcn_s_sleep(1); \
    if ((++_sp & 255u) == 0u) { if (xb_ld(&(bar)[XB_TMO])) break; if (_sp > XB_SPIN_CAP) { atomicAdd(&(bar)[XB_TMO], 1u); break; } } } } while (0)

struct XcdBarrier {
    unsigned* bar; unsigned x;
    volatile LAS unsigned* st;
};

__device__ __forceinline__ XcdBarrier xcd_barrier_post(unsigned* bar, volatile LAS unsigned* st) {
    XcdBarrier b; b.bar = bar; b.x = xb_xcc_id(); b.st = st;
    if (threadIdx.x == 0) (void)xb_add(&bar[XB_XCNT(b.x)], 1u);
    return b;
}
__device__ __forceinline__ void xcd_barrier_complete(unsigned* bar, unsigned x, unsigned& nloc, unsigned& nx) {
    const unsigned G = gridDim.x * gridDim.y * gridDim.z;
    unsigned sum, cnt, mine, sp = 0u;
    for (;;) {
        sum = 0u; cnt = 0u; mine = 0u;
#pragma unroll
        for (unsigned j = 0; j < 16; ++j) { const unsigned c = xb_ld(&bar[XB_XCNT(j)]); sum += c; cnt += (c > 0u) ? 1u : 0u; mine = (j == x) ? c : mine; }
        if (sum == G) break;
        __builtin_amdgcn_s_sleep(1);
        if ((++sp & 255u) == 0u) { if (xb_ld(&bar[XB_TMO])) break; if (sp > XB_SPIN_CAP) { atomicAdd(&bar[XB_TMO], 1u); break; } }
    }
    nloc = mine > 0u ? mine : 1u; nx = cnt > 0u ? cnt : 1u;
}

__device__ __forceinline__ void xcd_barrier(const XcdBarrier& b) {
    asm volatile("s_waitcnt vmcnt(0)" ::: "memory");
    __syncthreads();
    if (threadIdx.x == 0) {
        unsigned* bar = b.bar;
        __builtin_amdgcn_s_waitcnt(0);
        unsigned nloc = b.st[0], nx = b.st[1];
        if (nloc == 0u) { xcd_barrier_complete(bar, b.x, nloc, nx); b.st[0] = nloc; b.st[1] = nx; }
        const unsigned old = xb_add(&bar[XB_XSUB(b.x)], 1u);
        const unsigned gen = old / nloc;
        if (old + 1u == (gen + 1u) * nloc) {
            __builtin_amdgcn_fence(__ATOMIC_RELEASE, "agent");
            asm volatile("s_waitcnt vmcnt(0)" ::: "memory");
            const unsigned og = xb_add(&bar[XB_TOP], 1u);
            const unsigned tg = og / nx;
            if (og + 1u == (tg + 1u) * nx) xb_add(&bar[XB_TOPGEN], 1u);
            else XB_SPIN(xb_ld(&bar[XB_TOPGEN]) == tg, bar);
            __builtin_amdgcn_fence(__ATOMIC_ACQUIRE, "agent");
            xb_add(&bar[XB_XGEN(b.x)], 1u);
            asm volatile("s_waitcnt vmcnt(0)" ::: "memory");
        } else {
            XB_SPIN(xb_ld(&bar[XB_XGEN(b.x)]) == gen, bar);
            __builtin_amdgcn_fence(__ATOMIC_ACQUIRE, "agent");
            asm volatile("s_waitcnt vmcnt(0)" ::: "memory");
        }
    }
    __syncthreads();
}

#ifndef REPMASK
#define REPMASK 0
#endif
struct Args { const float* in[15]; float* out; unsigned char* ws; };
__global__ void __launch_bounds__(NTHR, 2) mk_fwd(Args a) {
    extern __shared__ __attribute__((aligned(16))) unsigned char lds_raw[];
    LAS unsigned char* lds = (LAS unsigned char*)lds_raw;
    cg::grid_group grid = cg::this_grid();
    const int tid = threadIdx.x, lane = tid & 63, wid = __builtin_amdgcn_readfirstlane(tid >> 6);
    const int G = gridDim.x, bx = blockIdx.x, vcu = (G % 8 == 0) ? (bx % 8) * (G / 8) + bx / 8 : bx;
    const int gw = vcu * NWAVES + wid, NGW = G * NWAVES, gtid = bx * NTHR + tid, NT = G * NTHR;
    unsigned char* ws = a.ws;
    volatile LAS unsigned* MISC = (volatile LAS unsigned*)(lds + 131072);
    if (tid < 64) MISC[tid] = 0u;
    __syncthreads();
    XcdBarrier xbar = xcd_barrier_post((unsigned*)(ws + WS_CTL), MISC + 8);
    const float* x = a.in[0]; const int* pos = (const int*)a.in[1]; const float* g_mix = a.in[2]; const float* w_in = a.in[3]; const float* g_q = a.in[4]; const float* w_q = a.in[5];
    const float* g_kv = a.in[6]; const float* w_kv = a.in[7]; const float* pool_w = a.in[8]; const float* pool_s = a.in[9]; const float* w_out = a.in[10]; const float* g_mlp = a.in[11];
    const float* w_up = a.in[12]; const float* w_dn = a.in[13]; const float* g_fin = a.in[14]; float* out = a.out;
    bf16_t* Win_t = (bf16_t*)(ws + WS_WIN); bf16_t* Wq_t = (bf16_t*)(ws + WS_WQ); bf16_t* Wk_t = (bf16_t*)(ws + WS_WK); bf16_t* Wv_t = (bf16_t*)(ws + WS_WV); bf16_t* Wo_t = (bf16_t*)(ws + WS_WO);
    bf16_t* Wup_t = (bf16_t*)(ws + WS_WUP); bf16_t* Wdn_t = (bf16_t*)(ws + WS_WDN);
    float* rope = (float*)(ws + WS_ROPE); float* rstd_x = (float*)(ws + WS_RSTDX); float* ssq_kv = (float*)(ws + WS_SSQKV); float* ssq_q = (float*)(ws + WS_SSQQ);
    float* ssq_h = (float*)(ws + WS_SSQH); float* ssq_o = (float*)(ws + WS_SSQO);
    bf16_t* Hb = (bf16_t*)(ws + WS_HB); bf16_t* Xb = (bf16_t*)(ws + WS_XB); bf16_t* Cq = (bf16_t*)(ws + WS_CQ); bf16_t* Ckv = (bf16_t*)(ws + WS_CKV); bf16_t* Kpe = (bf16_t*)(ws + WS_KPE);
    bf16_t* U = (bf16_t*)(ws + WS_U); bf16_t* Qb = (bf16_t*)(ws + WS_Q); bf16_t* Kn = (bf16_t*)(ws + WS_KN); bf16_t* Vt = (bf16_t*)(ws + WS_VT); bf16_t* Mix = (bf16_t*)(ws + WS_MIX);
    bf16_t* Act = (bf16_t*)(ws + WS_ACT); bf16_t* H2b = (bf16_t*)(ws + WS_H2);

    for (int rep_ = 0; rep_ <= ((REPMASK >> 0) & 1); ++rep_) {
    {
        LAS float* scr = (LAS float*)(lds + wid * 16384);
        constexpr int I_IN = 16 * (N1 / 32), I_Q = 6 * 24, I_K = 4 * 16, I_V = 4 * 16, I_O = 8 * 32, I_UP = 16 * 128, I_DN = 64 * 32;
        constexpr int NITEMS = I_IN + I_Q + I_K + I_V + I_O + I_UP + I_DN;
        for (int it = gw; it < NITEMS; it += NGW) {
            int r = it;
            if (r < I_UP) { tr_item<4>(w_up, FF, g_mlp, Wup_t, DM, FF / 32, scr, r, lane); continue; } r -= I_UP;
            if (r < I_DN) { tr_item<4>(w_dn, DM, nullptr, Wdn_t, FF, DM / 32, scr, r, lane); continue; } r -= I_DN;
            if (r < I_IN) { tr_item<0>(w_in, INW, g_mix, Win_t, DM, N1 / 32, scr, r, lane); continue; } r -= I_IN;
            if (r < I_Q) { tr_item<1>(w_q, 768, g_q, Wq_t, QL, 24, scr, r, lane); continue; } r -= I_Q;
            if (r < I_K) { tr_item<2>(w_kv, 1024, g_kv, Wk_t, KVL, 16, scr, r, lane); continue; } r -= I_K;
            if (r < I_V) { tr_item<3>(w_kv, 1024, g_kv, Wv_t, KVL, 16, scr, r, lane); continue; } r -= I_V;
            tr_item<4>(w_out, DM, nullptr, Wo_t, DM, 32, scr, r, lane);
        }
        for (int wi = gw; wi < 1024; wi += NGW) {
            const int nb = wi & 15, c8 = (wi >> 4) & 15, gg = wi >> 8, n = nb * 64 + lane;
            float accv[8];
#pragma unroll
            for (int cc = 0; cc < 8; ++cc) accv[cc] = 0.f;
            const float* pw = pool_w + (size_t)(gg * 128 + c8 * 8) * 128; const float* ps = pool_s + gg * 128; const float* wo = w_out + (size_t)(512 + gg * 128) * DM + n;
#pragma unroll 16
            for (int d = 0; d < 128; ++d) { const float wv = wo[(size_t)d * DM] * ps[d];
#pragma unroll
                for (int cc = 0; cc < 8; ++cc) accv[cc] += pw[cc * 128 + d] * wv; }
            u32x4 o; o.x = cvt_pk_bf16(accv[0], accv[1]); o.y = cvt_pk_bf16(accv[2], accv[3]); o.z = cvt_pk_bf16(accv[4], accv[5]); o.w = cvt_pk_bf16(accv[6], accv[7]);
            *(u32x4*)(Wo_t + (size_t)n * DM + 512 + gg * 128 + c8 * 8) = o;
        }
        for (int it = gtid; it < T * 32; it += NT) {
            const int row = it >> 5, i = it & 31;
            const float inv = exp2f(-(float)i * (13.287712379549449f / 32.0f));
            const float ang = (float)pos[row] * inv;
            double rev = (double)ang * 0.15915494309189535; rev -= rint(rev);
            const float fr_ = (float)rev;
            rope[2 * it] = __builtin_amdgcn_cosf(fr_); rope[2 * it + 1] = __builtin_amdgcn_sinf(fr_);
        }
        for (int row = gw; row < T; row += NGW) {
            const f32x4* xr = (const f32x4*)(x + (size_t)row * DM) + lane;
            f32x4 v[4]; float s = 0.f;
#pragma unroll
            for (int j = 0; j < 4; ++j) { v[j] = xr[64 * j]; s += dot4(v[j]); }
            s = wave_sum(s);
            if (lane == 0) rstd_x[row] = rsqrtf(s * (1.0f / DM) + EPS);
            u32x2* o8 = (u32x2*)(Xb + (size_t)row * DM) + lane;
#pragma unroll
            for (int j = 0; j < 4; ++j) o8[64 * j] = pack4(v[j]);
        }
    }
    }
    if (gridDim.y != 1) grid.sync();
    xcd_barrier(xbar);
    for (int rep_ = 0; rep_ <= ((REPMASK >> 1) & 1); ++rep_) {
    {
        pg8::Gemm g{Xb, Win_t, T, N1, DM}; pg8::StaticOrder S; S.init(T, N1, G, bx);
        Epi1 E{rstd_x, rope, Ckv, Cq, Kpe, U, ssq_kv, ssq_q};
        pg8::gemm_phase<Epi1, pg8::StaticOrder, true, true>(lds, g, S, E);
    }
    }
    xcd_barrier(xbar);
    for (int rep_ = 0; rep_ <= ((REPMASK >> 2) & 1); ++rep_) {
    {
        for (int wi = gw; wi < 4 * (T / 32); wi += NGW) {
            const int gg = wi & 3, chunk = wi >> 2;
            if (gg == 0) pool_item<2>(U, Mix, chunk, 0, lane); else if (gg == 1) pool_item<4>(U, Mix, chunk, 1, lane);
            else if (gg == 2) pool_item<8>(U, Mix, chunk, 2, lane); else pool_item<16>(U, Mix, chunk, 3, lane);
        }
        { pg8::Gemm g{Cq, Wq_t, T, 768, QL}; pg8::StaticOrder S; S.init(T, 768, G, bx); Epi2 E{ssq_q, rope, Qb};
          pg8::gemm_phase<Epi2, pg8::StaticOrder, true, true>(lds, g, S, E); }
        { pg8::Gemm g{Ckv, Wk_t, T, 512, KVL}; pg8::StaticOrder S; S.init(T, 512, G, bx); Epi3a E{ssq_kv, Kn};
          pg8::gemm_phase<Epi3a, pg8::StaticOrder, true, true>(lds, g, S, E); }
        { pg8::Gemm g{Wv_t, Ckv, 512, T, KVL}; pg8::StaticOrder S; S.init(512, T, G, bx); Epi3b E{ssq_kv, Vt};
          pg8::gemm_phase<Epi3b, pg8::StaticOrder, true, true>(lds, g, S, E); }
    }
    }
    xcd_barrier(xbar);
    for (int rep_ = 0; rep_ <= ((REPMASK >> 3) & 1); ++rep_) {
    for (int p = vcu; p < 256; p += G) {
        const int bh = p >> 2, pi = p & 3, b = bh >> 2, h = bh & 3;
        attn_unit(lds, Qb, Kn, Kpe, Vt, Mix, b, h, 7 - pi, tid, wid, lane);
        attn_unit(lds, Qb, Kn, Kpe, Vt, Mix, b, h, pi, tid, wid, lane);
    }
    }
    xcd_barrier(xbar);
    for (int rep_ = 0; rep_ <= ((REPMASK >> 4) & 1); ++rep_) {
    {
        pg8::Gemm g{Mix, Wo_t, T, DM, DM}; pg8::StaticOrder S; S.init(T, DM, G, bx); Epi4 E{Xb, Hb, ssq_h};
        pg8::gemm_phase<Epi4, pg8::StaticOrder, true, true>(lds, g, S, E);
    }
    }
    xcd_barrier(xbar);
    for (int rep_ = 0; rep_ <= ((REPMASK >> 5) & 1); ++rep_) {
    {
        pg8::Gemm g{Hb, Wup_t, T, FF, DM}; pg8::StaticOrder S; S.init(T, FF, G, bx); Epi5 E{ssq_h, Act};
        pg8::gemm_phase<Epi5, pg8::StaticOrder, true, true>(lds, g, S, E);
    }
    }
    xcd_barrier(xbar);
    for (int rep_ = 0; rep_ <= ((REPMASK >> 6) & 1); ++rep_) {
    {
        pg8::Gemm g{Act, Wdn_t, T, DM, FF}; pg8::StaticOrder S; S.init(T, DM, G, bx); Epi6 E{Hb, H2b, ssq_o};
        pg8::gemm_phase<Epi6, pg8::StaticOrder, true, true>(lds, g, S, E);
    }
    }
    xcd_barrier(xbar);
    for (int rep_ = 0; rep_ <= ((REPMASK >> 7) & 1); ++rep_) {
#ifdef XSYNC
    for (int xs_ = 0; xs_ < XSYNC; ++xs_) xcd_barrier(xbar);
#endif
    for (int row = gw; row < T; row += NGW) {
        float s = ssq_o[row * 16 + (lane & 15)];
        s += __shfl_xor(s, 1); s += __shfl_xor(s, 2); s += __shfl_xor(s, 4); s += __shfl_xor(s, 8);
        const float rs = rsqrtf(s * (1.0f / DM) + EPS);
        f32x4* orow = (f32x4*)(out + (size_t)row * DM) + lane; const u32x2* hrow = (const u32x2*)(H2b + (size_t)row * DM) + lane; const f32x4* gr = (const f32x4*)g_fin + lane;
#pragma unroll
        for (int j = 0; j < 4; ++j) { const u32x2 r = hrow[64 * j];
            const f32x4 hv = {__uint_as_float(r[0] << 16), __uint_as_float(r[0] & 0xffff0000u), __uint_as_float(r[1] << 16), __uint_as_float(r[1] & 0xffff0000u)};
            orow[64 * j] = hv * rs * gr[64 * j]; }
    }
    }
}

extern "C" void kernel_launch(void* const* d_in, const int* in_sizes, int n_in, void* d_out, int out_size, void* d_ws, size_t ws_size, hipStream_t stream) {
    static int grid = 0;
    if (grid == 0) {
        if (n_in != 15 || in_sizes[0] != T * DM || out_size != T * DM || ws_size < WS_END) { fprintf(stderr, "kernel_launch: unexpected shapes (n_in %d, in0 %d, out %d, ws %zu); nothing launched\n", n_in, n_in > 0 ? in_sizes[0] : -1, out_size, ws_size); grid = -1; return; }
        int dev = 0, cus = 0, per_cu = 0;
        if (hipGetDevice(&dev) != hipSuccess || hipDeviceGetAttribute(&cus, hipDeviceAttributeMultiprocessorCount, dev) != hipSuccess) { grid = -1; return; }
        if (hipFuncSetAttribute((const void*)mk_fwd, hipFuncAttributeMaxDynamicSharedMemorySize, LDS_BYTES) != hipSuccess) { fprintf(stderr, "kernel_launch: hipFuncSetAttribute failed\n"); grid = -1; return; }
        if (hipOccupancyMaxActiveBlocksPerMultiprocessor(&per_cu, (const void*)mk_fwd, NTHR, LDS_BYTES) != hipSuccess || per_cu < 1) per_cu = 1;
        (void)hipGetLastError();
        grid = cus * per_cu;
    }
    if (grid < 0) return;
    if (hipMemsetAsync((char*)d_ws + WS_CTL, 0, CTL_BYTES, stream) != hipSuccess) { fprintf(stderr, "kernel_launch: memset of the barrier words failed\n"); return; }
    Args a{};
    for (int i = 0; i < 15; ++i) a.in[i] = (const float*)d_in[i];
    a.out = (float*)d_out; a.ws = (unsigned char*)d_ws;
    void* args[] = {&a};
    const hipError_t e = hipLaunchCooperativeKernel((const void*)mk_fwd, dim3(grid), dim3(NTHR), args, LDS_BYTES, stream);
    if (e != hipSuccess) fprintf(stderr, "kernel_launch: cooperative launch failed: %s (grid %d)\n", hipGetErrorString(e), grid);
}
```
